# Optimizing an MI355X kernel written in HIP

```python
import math
import jax, jax.numpy as jnp
from jax import lax
import numpy as np

D_MODEL = 1024
BATCH = 4
SEQ = 8192
DEPTH = 1

N_META = 16
CONV_WIDTH = D_MODEL // 2
CONV_K = 3
N_HEADS = 4
HEAD_DIM = 64
V_DIM = 2 * HEAD_DIM
QK_WIDTH = N_HEADS * 2 * HEAD_DIM
ATTN_WIDTH = N_HEADS * V_DIM
MIX_WIDTH = CONV_WIDTH + ATTN_WIDTH
IN_COLS = 3 * CONV_WIDTH + 2 * QK_WIDTH + ATTN_WIDTH
ROPE_DIM = HEAD_DIM // 4
ROPE_THETA = 500000.0
Q_BLOCK = 128
N_GROUPS = 4
EXPERTS_PER_GROUP = 8
N_EXPERTS = N_GROUPS * EXPERTS_PER_GROUP
TOP_K = 2
D_FF_EXPERT = D_MODEL // 2
MOE_BLOCK = 256
EPS = 1e-6

kernel_name = "hymba_conv_diffattn_hiermoe_layer"


def rms_norm(x, g):
    xf = x.astype(jnp.float32)
    y = xf * lax.rsqrt(jnp.mean(xf * xf, axis=-1, keepdims=True) + EPS)
    return y.astype(x.dtype) * g.astype(x.dtype)


def partial_rope(t, cos, sin):
    half = ROPE_DIM // 2
    r1 = t[..., :half]
    r2 = t[..., half:ROPE_DIM]
    rest = t[..., ROPE_DIM:]
    return jnp.concatenate([r1 * cos - r2 * sin, r2 * cos + r1 * sin, rest], axis=-1)


def causal_depthwise_conv(z, w):
    return lax.conv_general_dilated(
        z, w[:, None, :].astype(z.dtype), window_strides=(1,),
        padding=[(CONV_K - 1, 0)], dimension_numbers=("NWC", "WIO", "NWC"),
        feature_group_count=z.shape[-1])


def diff_attention(q, k, v, lam):
    _, b, h, lp, _ = q.shape
    nb = lp // Q_BLOCK
    scale = HEAD_DIM ** -0.5
    qb = q.reshape(2, b, h, nb, Q_BLOCK, HEAD_DIM).transpose(3, 0, 1, 2, 4, 5)
    kpos = jnp.arange(lp)

    def one_block(args):
        qblk, i = args
        qpos = i * Q_BLOCK + jnp.arange(Q_BLOCK)
        mask = qpos[:, None] >= kpos[None, :]
        s = jnp.einsum("nbhqd,nbhkd->nbhqk", qblk, k).astype(jnp.float32) * scale
        p = jax.nn.softmax(jnp.where(mask, s, -jnp.inf), axis=-1)
        w = p[0] - lam * p[1]
        return jnp.einsum("bhqk,bhkd->bhqd", w.astype(v.dtype), v)

    out = lax.map(one_block, (qb, jnp.arange(nb)))
    return out.transpose(1, 2, 0, 3, 4).reshape(b, h, lp, V_DIM)


def hier_moe(t, w_rg, b_rg, w_re, b_re, w_gate, w_up, w_down):
    n = t.shape[0]
    tf = t.astype(jnp.float32)
    g_prob = jax.nn.softmax(tf @ w_rg.astype(jnp.float32) + b_rg.astype(jnp.float32), axis=-1)
    g_val, g_idx = lax.top_k(g_prob, 1)
    e_logits = (tf @ w_re.astype(jnp.float32) + b_re.astype(jnp.float32)).reshape(n, N_GROUPS, EXPERTS_PER_GROUP)
    e_sel = jnp.take_along_axis(e_logits, g_idx[:, :, None], axis=1)[:, 0]
    e_val, e_idx = lax.top_k(jax.nn.softmax(e_sel, axis=-1), TOP_K)
    gates = (g_val * e_val / jnp.sum(e_val, axis=-1, keepdims=True)).reshape(-1).astype(t.dtype)
    expert_ids = (g_idx * EXPERTS_PER_GROUP + e_idx).reshape(-1).astype(jnp.int32)
    token_ids = jnp.repeat(jnp.arange(n, dtype=jnp.int32), TOP_K)

    a = n * TOP_K
    n_blocks = -(-a // MOE_BLOCK) + N_EXPERTS
    p_rows = n_blocks * MOE_BLOCK
    order = jnp.argsort(expert_ids, stable=True)
    sorted_e = expert_ids[order]
    counts = jnp.bincount(expert_ids, length=N_EXPERTS)
    padded = (counts + MOE_BLOCK - 1) // MOE_BLOCK * MOE_BLOCK
    starts = jnp.cumsum(counts) - counts
    pends = jnp.cumsum(padded)
    pstarts = pends - padded
    dest = pstarts[sorted_e] + (jnp.arange(a) - starts[sorted_e])
    buf_tok = jnp.full((p_rows,), n, jnp.int32).at[dest].set(token_ids[order])
    buf_gate = jnp.zeros((p_rows,), t.dtype).at[dest].set(gates[order])
    block_e = jnp.minimum(jnp.searchsorted(pends, jnp.arange(n_blocks) * MOE_BLOCK, side="right"),
                          N_EXPERTS - 1)
    t_pad = jnp.concatenate([t, jnp.zeros((1, t.shape[1]), t.dtype)], axis=0)
    xb = t_pad[buf_tok].reshape(n_blocks, MOE_BLOCK, t.shape[1])

    def expert_block(args):
        xe, e = args
        hid = jax.nn.silu(xe @ w_gate[e]) * (xe @ w_up[e])
        return hid @ w_down[e]

    yb = lax.map(expert_block, (xb, block_e)).reshape(p_rows, t.shape[1])
    out = jnp.zeros((n + 1, t.shape[1]), t.dtype).at[buf_tok].add(yb * buf_gate[:, None])
    return out[:n]


def setup_inputs(seed: int = 0) -> dict:
    key = jax.random.key(seed)
    ks = jax.random.split(key, 24)
    f32 = jnp.float32
    nrm = lambda k, shape, s: jax.random.normal(k, shape, f32) * s
    return {
        "x": nrm(ks[0], (BATCH, SEQ, D_MODEL), 1.0),
        "meta_tokens": nrm(ks[1], (N_META, D_MODEL), 1.0),
        "norm1_g": 1.0 + nrm(ks[2], (DEPTH, D_MODEL), 0.02),
        "w_in": nrm(ks[3], (DEPTH, D_MODEL, IN_COLS), D_MODEL ** -0.5),
        "conv_w": nrm(ks[4], (DEPTH, CONV_K, CONV_WIDTH), CONV_K ** -0.5),
        "q_norm_g": 1.0 + nrm(ks[5], (DEPTH, HEAD_DIM), 0.02),
        "k_norm_g": 1.0 + nrm(ks[6], (DEPTH, HEAD_DIM), 0.02),
        "lambda_q1": nrm(ks[7], (DEPTH, HEAD_DIM), 0.1),
        "lambda_k1": nrm(ks[8], (DEPTH, HEAD_DIM), 0.1),
        "lambda_q2": nrm(ks[9], (DEPTH, HEAD_DIM), 0.1),
        "lambda_k2": nrm(ks[10], (DEPTH, HEAD_DIM), 0.1),
        "subln_g": 1.0 + nrm(ks[11], (DEPTH, V_DIM), 0.02),
        "w_out": nrm(ks[12], (DEPTH, MIX_WIDTH, D_MODEL), MIX_WIDTH ** -0.5),
        "norm2_g": 1.0 + nrm(ks[13], (DEPTH, D_MODEL), 0.02),
        "w_router_group": nrm(ks[14], (DEPTH, D_MODEL, N_GROUPS), D_MODEL ** -0.5),
        "b_router_group": nrm(ks[15], (DEPTH, N_GROUPS), 0.01),
        "w_router_expert": nrm(ks[16], (DEPTH, D_MODEL, N_EXPERTS), D_MODEL ** -0.5),
        "b_router_expert": nrm(ks[17], (DEPTH, N_EXPERTS), 0.01),
        "w_gate": nrm(ks[18], (DEPTH, N_EXPERTS, D_MODEL, D_FF_EXPERT), D_MODEL ** -0.5),
        "w_up": nrm(ks[19], (DEPTH, N_EXPERTS, D_MODEL, D_FF_EXPERT), D_MODEL ** -0.5),
        "w_down": nrm(ks[20], (DEPTH, N_EXPERTS, D_FF_EXPERT, D_MODEL), D_FF_EXPERT ** -0.5),
    }


def reference(x, meta_tokens, norm1_g, w_in, conv_w, q_norm_g, k_norm_g, lambda_q1, lambda_k1,
              lambda_q2, lambda_k2, subln_g, w_out, norm2_g, w_router_group, b_router_group,
              w_router_expert, b_router_expert, w_gate, w_up, w_down):
    b, s, d = x.shape
    h = jnp.concatenate([jnp.broadcast_to(meta_tokens[None].astype(x.dtype), (b, N_META, d)), x], axis=1)
    length = s + N_META
    lp = -(-length // Q_BLOCK) * Q_BLOCK

    pos = jnp.arange(length, dtype=jnp.float32)
    inv_freq = ROPE_THETA ** (-jnp.arange(0, ROPE_DIM, 2, dtype=jnp.float32) / ROPE_DIM)
    ang = pos[:, None] * inv_freq[None, :]
    cos = jnp.cos(ang).astype(x.dtype)
    sin = jnp.sin(ang).astype(x.dtype)

    for l in range(DEPTH):
        lam_init = 0.8 - 0.6 * math.exp(-0.3 * l)
        xn = rms_norm(h, norm1_g[l])
        u = xn @ w_in[l]
        c_b, c_c, c_x, q, k, v = jnp.split(
            u, [CONV_WIDTH, 2 * CONV_WIDTH, 3 * CONV_WIDTH, 3 * CONV_WIDTH + QK_WIDTH,
                3 * CONV_WIDTH + 2 * QK_WIDTH], axis=-1)
        conv_y = c_b * causal_depthwise_conv(c_c * c_x, conv_w[l])

        q = q.reshape(b, length, N_HEADS, 2, HEAD_DIM).transpose(3, 0, 2, 1, 4)
        k = k.reshape(b, length, N_HEADS, 2, HEAD_DIM).transpose(3, 0, 2, 1, 4)
        q = partial_rope(rms_norm(q, q_norm_g[l]), cos, sin)
        k = partial_rope(rms_norm(k, k_norm_g[l]), cos, sin)
        v = v.reshape(b, length, N_HEADS, V_DIM).transpose(0, 2, 1, 3)
        pad = lp - length
        q = jnp.pad(q, ((0, 0), (0, 0), (0, 0), (0, pad), (0, 0)))
        k = jnp.pad(k, ((0, 0), (0, 0), (0, 0), (0, pad), (0, 0)))
        v = jnp.pad(v, ((0, 0), (0, 0), (0, pad), (0, 0)))
        lam = (jnp.exp(jnp.sum(lambda_q1[l].astype(jnp.float32) * lambda_k1[l].astype(jnp.float32)))
               - jnp.exp(jnp.sum(lambda_q2[l].astype(jnp.float32) * lambda_k2[l].astype(jnp.float32)))
               + lam_init)
        o = diff_attention(q, k, v, lam)[:, :, :length]
        o = rms_norm(o, subln_g[l]) * (1.0 - lam_init)
        o = o.transpose(0, 2, 1, 3).reshape(b, length, ATTN_WIDTH)
        h = h + jnp.concatenate([conv_y, o], axis=-1) @ w_out[l]

        xn2 = rms_norm(h, norm2_g[l]).reshape(b * length, d)
        h = h + hier_moe(xn2, w_router_group[l], b_router_group[l], w_router_expert[l],
                         b_router_expert[l], w_gate[l], w_up[l], w_down[l]).reshape(b, length, d)

    return h[:, N_META:]
```

```cpp
#include <hip/hip_runtime.h>
#include <cstdio>
#include <cstdint>
#include <cmath>

#define HD_INL __host__ __device__ __forceinline__
#define GAS __attribute__((address_space(1)))
#define LAS __attribute__((address_space(3)))
typedef unsigned short bf16;
typedef unsigned v4u __attribute__((ext_vector_type(4)));
typedef float f32x4 __attribute__((ext_vector_type(4)));
typedef float f32x16 __attribute__((ext_vector_type(16)));
typedef short bf16x8 __attribute__((ext_vector_type(8)));
typedef short s16x4 __attribute__((ext_vector_type(4)));
typedef GAS unsigned gu32;
#define RLX_AGENT __ATOMIC_RELAXED, __HIP_MEMORY_SCOPE_AGENT
#define LDS_WAIT() asm volatile("s_waitcnt lgkmcnt(0)" ::: "memory")
#define VM_WAIT() asm volatile("s_waitcnt vmcnt(0)" ::: "memory")

constexpr int DM = 1024, BATCH = 4, SEQ = 8192, NMETA = 16;
constexpr int NTOK = BATCH * SEQ;
constexpr int MROWS = NTOK + 256;
constexpr int CONVW = 512, NHEAD = 4, HDIM = 64, VDIM = 128, INCOLS = 3072;
constexpr int NEXP = 32, DFF = 512, NGRP = 4, EPG = 8;
constexpr int KVT = SEQ / 64 + 1;
constexpr int CCXROWS = SEQ + 2;
constexpr int CAP = NTOK;
constexpr float EPS = 1e-6f;
constexpr float QSCALE = 0.125f * 1.4426950408889634f;

constexpr size_t MiB = 1u << 20;
constexpr size_t WS_CTL = 0, CTL_ZERO_BYTES = 1 * MiB;
constexpr size_t WS_RSTD1 = 1 * MiB, WS_RSTD2 = 1 * MiB + 512 * 1024, WS_ROPEC = 2 * MiB, WS_ROPES = 2 * MiB + 512 * 1024, WS_WR = 3 * MiB, WS_MISCF = 3 * MiB + 512 * 1024;
constexpr size_t WS_WIN = 4 * MiB, WS_WOUT = 10 * MiB, WS_WGU = 12 * MiB, WS_WD = 76 * MiB;
constexpr size_t WS_ROWPAIR = 108 * MiB, WS_ROWGATE = 112 * MiB;
constexpr size_t WS_XB = 116 * MiB;
constexpr size_t WS_MIX = 181 * MiB;
constexpr size_t WS_Y = 116 * MiB;
constexpr size_t WS_CB = 245 * MiB, WS_CCX = 277 * MiB, WS_Q = 310 * MiB;
constexpr size_t WS_HID = 245 * MiB;
constexpr size_t WS_K = 342 * MiB, WS_V = 375 * MiB, WS_END = 408 * MiB;
static_assert(WS_XB + (size_t)MROWS * DM * 2 <= WS_MIX && WS_Y + (size_t)2 * NTOK * DM * 2 <= WS_CB && WS_HID + (size_t)288 * 256 * DFF * 2 <= WS_K, "ws map");
static_assert(WS_CCX + (size_t)BATCH * CCXROWS * CONVW * 2 <= WS_Q && WS_K + (size_t)BATCH * NHEAD * KVT * 16384 <= WS_V && WS_V + (size_t)BATCH * NHEAD * KVT * 16384 <= WS_END, "ws map 2");
constexpr int CW_TMO = 0, CW_CODE = 1, CW_ERR = 16  , CW_BAR = 4096, CW_CNT = 16384  ;

HD_INL int qk_delta(int chunk, int e) { const int bj = chunk >> 2, fq = chunk & 3; if (bj == 0 && fq < 2) return e < 4 ? 4 * fq + e : 8 + 4 * fq + (e - 4); return bj == 0 ? 8 * fq + e : 32 + 8 * fq + e; }
HD_INL size_t q_off(int b, int head, int mp, int i, int chunk) { return ((((size_t)(b * 4 + head) * 2 + mp) * 256 + (i >> 5)) * 8 + chunk) * 256 + (size_t)(i & 31) * 8; }
HD_INL size_t k_off(int b, int head, int t, int mp, int chunk, int row) { return (((size_t)(b * 4 + head) * KVT + t) * 2 + mp) * 4096 + (size_t)chunk * 512 + (size_t)row * 8; }
HD_INL size_t v_off(int b, int head, int t, int dq, int row, int dcol) { return ((size_t)(b * 4 + head) * KVT + t) * 8192 + (size_t)dq * 2048 + (size_t)(row >> 4) * 512 + (size_t)(row & 15) * 32 + dcol; }
HD_INL int inproj_col(int n) {
    const int pn = n >> 8, p = n & 255, bj = p >> 7, x = p & 127;
    if (pn < 2 || pn >= 10) return n;
    if (pn < 6) return (bj ? 1024 : 512) + 128 * (pn - 2) + x;
    const int wc = x >> 5, fq = (x >> 3) & 3, e = x & 7;
    return 1536 + 256 * (pn - 6) + 64 * wc + qk_delta(4 * bj + fq, e);
}

namespace pg8 {
#define PG8_LAS __attribute__((address_space(3)))
typedef unsigned short bf16_t;
typedef unsigned u32x4 __attribute__((ext_vector_type(4)));
constexpr int BM = 256, BK = 64, HALF = 128, HTB = HALF * BK * 2  , STAGE_BYTES = 8 * HTB, NXCD = 8, WGM = 8;

__host__ __device__ __forceinline__ int lds_byte(int r, int c) { const int st = (r >> 4) * 2 + (c >> 5), rr = r & 15, cc = c & 31, ob = rr * 64 + cc * 2; return st * 1024 + (ob ^ (((ob >> 9) & 1) << 5)); }
__host__ __device__ __forceinline__ void stage_rc(int b, int& R, int& C) { const int st = b / 1024, sb = b % 1024, swz = sb ^ (((sb >> 9) & 1) << 5); R = (st >> 1) * 16 + swz / 64; C = (st & 1) * 32 + (swz % 64) / 2; }
__host__ __device__ __forceinline__ int perm32(int rho) { const int n = rho >> 4, i = rho & 15; return 8 * (i >> 2) + 4 * n + (i & 3); }

struct Unit { int pm, pn; };
struct Gemm { const bf16_t* A; const bf16_t* Bt; int M, N, K; };

struct StaticOrder {
    int nM, nN, nwg, G, c;
    __host__ __device__ void init(int M, int N, int G_, int c_) { nM = M / BM; nN = N / BM; nwg = nM * nN; G = G_; c = c_; }
    __host__ __device__ bool next(int i, Unit& u) const {
        const long L = (long)i * G + c; if (L >= nwg) return false;
        int wgid = (int)L; { const int q = nwg / NXCD, r = nwg % NXCD, xcd = wgid % NXCD, off = wgid / NXCD; wgid = (xcd < r ? xcd * (q + 1) : r * (q + 1) + (xcd - r) * q) + off; }
        const int nig = WGM * nN, gid = wgid / nig, fm = gid * WGM, gsz = (nM - fm) < WGM ? (nM - fm) : WGM;
        u.pm = fm + ((wgid % nig) % gsz); u.pn = (wgid % nig) / gsz; return true;
    }
    __device__ __forceinline__ unsigned arow_off(const Unit&, int) const { return 0u; }
};

__device__ __forceinline__ unsigned cvt_pk_bf16(float lo, float hi) { unsigned r; asm volatile("v_cvt_pk_bf16_f32 %0, %1, %2" : "=v"(r) : "v"(lo), "v"(hi)); return r; }
__device__ __forceinline__ u32x4 pack8(const f32x4 a, const f32x4 b) { u32x4 w; w.x = cvt_pk_bf16(a[0], a[1]); w.y = cvt_pk_bf16(a[2], a[3]); w.z = cvt_pk_bf16(b[0], b[1]); w.w = cvt_pk_bf16(b[2], b[3]); return w; }

template <class Epi, class Sched, bool ALIGN_EPI, bool GATHER>
__device__ __forceinline__ void gemm_phase(PG8_LAS unsigned char* lds, const Gemm g, const Sched& S, const Epi& E) {
    const int tid = threadIdx.x, wid = __builtin_amdgcn_readfirstlane(tid >> 6), lane = tid & 63, wr = wid >> 2, wc = wid & 3, fr = lane & 15, fq = lane >> 4;
    const int K = g.K, nt = K / BK;
    unsigned voffA[2], voffB[2];
#pragma unroll
    for (int i = 0; i < 2; ++i) { int R, C; stage_rc(tid * 16 + i * 8192, R, C); const int Rb = Epi::PERM ? ((R & ~31) + perm32(R & 31)) : R;
        voffA[i] = (unsigned)(R * K + C) * 2u; voffB[i] = (unsigned)(Rb * K + C) * 2u; }
    const size_t kstep = (size_t)(BK * 2);
    const size_t hstep = (size_t)HALF * K * 2;
    const size_t tstep = 2 * hstep;
    const unsigned ldsw = (unsigned)wid * 1024u;
    const int aoff = lds_byte(wr * 64 + fr, fq * 8), boff = lds_byte(wc * 32 + fr, fq * 8);
    unsigned cvo[2][2];
#define PG8_SA(b, h) (((b) * 2 + (h)) * HTB)
#define PG8_SB(b, h) ((4 + (b) * 2 + (h)) * HTB)
#define PG8_STAGE(bufoff, gbase, voff) do { _Pragma("unroll") for (int _i = 0; _i < 2; ++_i) \
        __builtin_amdgcn_global_load_lds((const unsigned*)((const char*)(gbase) + (voff)[_i]), (PG8_LAS unsigned*)(lds + (bufoff) + ldsw + _i * 8192), 16, 0, 0); } while (0)
#define PG8_STGA(bufoff, gbase, hh, USE_NEXT) do { if constexpr (GATHER) { _Pragma("unroll") for (int _i = 0; _i < 2; ++_i) { \
        __builtin_amdgcn_global_load_lds((const unsigned*)((const char*)(gbase) + cvo[hh][_i]), (PG8_LAS unsigned*)(lds + (bufoff) + ldsw + _i * 8192), 16, 0, 0); } } \
        else { PG8_STAGE(bufoff, (gbase) + (hh) * hstep, voffA); } } while (0)
#define PG8_LDA(dst, b, h) do { _Pragma("unroll") for (int m = 0; m < 4; ++m) _Pragma("unroll") for (int k = 0; k < 2; ++k) dst[m][k] = *(const PG8_LAS bf16x8*)(lds + PG8_SA(b, h) + aoff + m * 2048 + k * 1024); } while (0)
#define PG8_LDB(dst, b, h) do { _Pragma("unroll") for (int n = 0; n < 2; ++n) _Pragma("unroll") for (int k = 0; k < 2; ++k) dst[n][k] = *(const PG8_LAS bf16x8*)(lds + PG8_SB(b, h) + boff + n * 2048 + k * 1024); } while (0)
#define PG8_MMA(ai, bj, At, Bt) do { __builtin_amdgcn_s_setprio(1); _Pragma("unroll") for (int m = 0; m < 4; ++m) _Pragma("unroll") for (int n = 0; n < 2; ++n) _Pragma("unroll") for (int k = 0; k < 2; ++k) \
        acc[ai][bj][m][n] = __builtin_amdgcn_mfma_f32_16x16x32_bf16(Bt[n][k], At[m][k], acc[ai][bj][m][n], 0, 0, 0); __builtin_amdgcn_s_setprio(0); } while (0)
#define PG8_WAIT_V(n) asm volatile("s_waitcnt vmcnt(" #n ")" ::: "memory")
#define PG8_WAIT_L(n) asm volatile("s_waitcnt lgkmcnt(" #n ")" ::: "memory")
#define PG8_BAR __builtin_amdgcn_s_barrier()
#define PG8_SCHED __builtin_amdgcn_sched_barrier(0)
#define PG8_GOFF(dst, un) do { if constexpr (GATHER) { _Pragma("unroll") for (int _i = 0; _i < 2; ++_i) { int R_, C_; stage_rc(tid * 16 + _i * 8192, R_, C_); \
        _Pragma("unroll") for (int _h = 0; _h < 2; ++_h) dst[_h][_i] = S.arow_off(un, _h * HALF + R_) + (unsigned)C_ * 2u; } } } while (0)
    Unit cur, nxt; int ui = 0;
    if (!S.next(0, cur)) return;
    f32x4 acc[2][2][4][2];
#pragma unroll
    for (int a = 0; a < 2; ++a)
#pragma unroll
        for (int b = 0; b < 2; ++b)
#pragma unroll
            for (int m = 0; m < 4; ++m)
#pragma unroll
                for (int n = 0; n < 2; ++n) acc[a][b][m][n] = (f32x4){0.f, 0.f, 0.f, 0.f};
    bf16x8 At[4][2], B0[2][2], B1[2][2];
    const char* cA = GATHER ? (const char*)g.A : (const char*)g.A + (size_t)cur.pm * tstep; const char* cB = (const char*)g.Bt + (size_t)cur.pn * tstep;
    PG8_GOFF(cvo, cur);
    PG8_STAGE(PG8_SB(0, 0), cB, voffB); PG8_STAGE(PG8_SB(0, 1), cB + hstep, voffB); PG8_STGA(PG8_SA(0, 0), cA, 0, false); PG8_STGA(PG8_SA(0, 1), cA, 1, false);
    if (wr == 1) PG8_BAR;
    PG8_WAIT_V(2); PG8_BAR;
    PG8_STAGE(PG8_SB(1, 0), cB + kstep, voffB); PG8_STGA(PG8_SA(1, 0), cA + kstep, 0, false); PG8_STAGE(PG8_SB(1, 1), cB + hstep + kstep, voffB);
    PG8_WAIT_V(6); PG8_BAR;
    for (;;) {
        const bool has_next = S.next(ui + 1, nxt);
        const char* nA = GATHER ? (const char*)g.A : (has_next ? (const char*)g.A + (size_t)nxt.pm * tstep : cA); const char* nB = has_next ? (const char*)g.Bt + (size_t)nxt.pn * tstep : cB;
        for (int t = 0; t < nt; t += 2) {
            const bool last = (t == nt - 2);
            const char* a1 = cA + (size_t)(t + 1) * kstep;
            const char* a2 = last ? nA : cA + (size_t)(t + 2) * kstep; const char* b2 = last ? nB : cB + (size_t)(t + 2) * kstep;
            const char* a3 = a2 + kstep; const char* b3 = b2 + kstep;
            PG8_LDB(B0, 0, 0); PG8_LDB(B1, 0, 1); PG8_SCHED; PG8_LDA(At, 0, 0); PG8_STGA(PG8_SA(1, 1), a1, 1, false);
            if constexpr (GATHER) { if (last && has_next) PG8_GOFF(cvo, nxt); }
            PG8_WAIT_V(8); PG8_WAIT_L(0); PG8_BAR; PG8_MMA(0, 0, At, B0); PG8_MMA(0, 1, At, B1); PG8_BAR; PG8_SCHED;
            PG8_LDA(At, 0, 1); PG8_STAGE(PG8_SB(0, 0), b2, voffB); PG8_STAGE(PG8_SB(0, 1), b2 + hstep, voffB); PG8_STGA(PG8_SA(0, 0), a2, 0, last);
            PG8_WAIT_V(8); PG8_WAIT_L(0); PG8_BAR; PG8_MMA(1, 0, At, B0); PG8_MMA(1, 1, At, B1); PG8_BAR; PG8_SCHED;
            PG8_LDB(B0, 1, 0); PG8_LDB(B1, 1, 1); PG8_SCHED; PG8_LDA(At, 1, 0); PG8_STGA(PG8_SA(0, 1), a2, 1, last);
            PG8_WAIT_V(8); PG8_WAIT_L(0); PG8_BAR; PG8_MMA(0, 0, At, B0); PG8_MMA(0, 1, At, B1); PG8_BAR; PG8_SCHED;
            PG8_LDA(At, 1, 1); PG8_STAGE(PG8_SB(1, 0), b3, voffB); PG8_STAGE(PG8_SB(1, 1), b3 + hstep, voffB); PG8_STGA(PG8_SA(1, 0), a3, 0, last);
            PG8_WAIT_V(8); PG8_WAIT_L(0); PG8_BAR; PG8_MMA(1, 0, At, B0); PG8_MMA(1, 1, At, B1); PG8_BAR; PG8_SCHED;
        }
        if constexpr (ALIGN_EPI) { if (wr == 0) PG8_BAR; }
        E(acc, cur, wr, wc, fr, fq);
        if (!has_next) break;
#pragma unroll
        for (int a = 0; a < 2; ++a)
#pragma unroll
            for (int b = 0; b < 2; ++b)
#pragma unroll
                for (int m = 0; m < 4; ++m)
#pragma unroll
                    for (int n = 0; n < 2; ++n) acc[a][b][m][n] = (f32x4){0.f, 0.f, 0.f, 0.f};
        cur = nxt; cA = nA; cB = nB; ++ui;
        if constexpr (ALIGN_EPI) { if (wr == 1) PG8_BAR; }
    }
    PG8_WAIT_V(0);
    if constexpr (!ALIGN_EPI) { if (wr == 0) PG8_BAR; }
    PG8_BAR;
#undef PG8_SA
#undef PG8_SB
#undef PG8_STAGE
#undef PG8_STGA
#undef PG8_LDA
#undef PG8_LDB
#undef PG8_MMA
#undef PG8_WAIT_V
#undef PG8_WAIT_L
#undef PG8_BAR
#undef PG8_SCHED
#undef PG8_GOFF
}
}
__device__ __forceinline__ unsigned long long rt() { return __builtin_amdgcn_s_memrealtime(); }
__device__ __forceinline__ unsigned f2bf(float f) { unsigned u = __builtin_bit_cast(unsigned, f); return (u + 0x7fffu + ((u >> 16) & 1u)) >> 16; }
__device__ __forceinline__ unsigned pk2(float lo, float hi) { return f2bf(lo) | (f2bf(hi) << 16); }
#define XB_TMO      128
#define XB_XCNT(j)  (256  + 64 * (j))
#define XB_XSUB(j)  (1280 + 64 * (j))
#define XB_XGEN(j)  (2304 + 64 * (j))
#define XB_TOP      3328
#define XB_TOPGEN   3392
#define XCD_BAR_WORDS 3456
#define XB_SPIN_CAP (1u << 18)

__device__ __forceinline__ unsigned xb_ld(unsigned* p)              { return __hip_atomic_load(p, __ATOMIC_RELAXED, __HIP_MEMORY_SCOPE_AGENT); }
__device__ __forceinline__ unsigned xb_add(unsigned* p, unsigned v) { return __hip_atomic_fetch_add(p, v, __ATOMIC_RELAXED, __HIP_MEMORY_SCOPE_AGENT); }
__device__ __forceinline__ unsigned xb_xcc_id() { return (unsigned)__builtin_amdgcn_s_getreg((3 << 11) | 20) & 0xFu; }
#define XB_SPIN(cond, bar) do { unsigned _sp = 0; while (cond) { __builtin_amdgcn_s_sleep(1); \
    if ((++_sp & 255u) == 0u) { if (xb_ld(&(bar)[XB_TMO])) break; if (_sp > XB_SPIN_CAP) { atomicAdd(&(bar)[XB_TMO], 1u); break; } } } } while (0)

struct XcdBarrier {
    unsigned* bar; unsigned x;
    volatile LAS unsigned* st;
};

__device__ __forceinline__ XcdBarrier xcd_barrier_post(unsigned* bar, volatile LAS unsigned* st) {
    XcdBarrier b; b.bar = bar; b.x = xb_xcc_id(); b.st = st;
    if (threadIdx.x == 0) (void)xb_add(&bar[XB_XCNT(b.x)], 1u);
    return b;
}
__device__ __forceinline__ void xcd_barrier_complete(unsigned* bar, unsigned x, unsigned& nloc, unsigned& nx) {
    const unsigned G = gridDim.x * gridDim.y * gridDim.z;
    unsigned sum, cnt, mine, sp = 0u;
    for (;;) {
        sum = 0u; cnt = 0u; mine = 0u;
#pragma unroll
        for (unsigned j = 0; j < 16; ++j) { const unsigned c = xb_ld(&bar[XB_XCNT(j)]); sum += c; cnt += (c > 0u) ? 1u : 0u; mine = (j == x) ? c : mine; }
        if (sum == G) break;
        __builtin_amdgcn_s_sleep(1);
        if ((++sp & 255u) == 0u) { if (xb_ld(&bar[XB_TMO])) break; if (sp > XB_SPIN_CAP) { atomicAdd(&bar[XB_TMO], 1u); break; } }
    }
    nloc = mine > 0u ? mine : 1u; nx = cnt > 0u ? cnt : 1u;
}

__device__ __forceinline__ void xcd_barrier(const XcdBarrier& b) {
    asm volatile("s_waitcnt vmcnt(0)" ::: "memory");
    __syncthreads();
    if (threadIdx.x == 0) {
        unsigned* bar = b.bar;
        __builtin_amdgcn_s_waitcnt(0);
        unsigned nloc = b.st[0], nx = b.st[1];
        if (nloc == 0u) { xcd_barrier_complete(bar, b.x, nloc, nx); b.st[0] = nloc; b.st[1] = nx; }
        const unsigned old = xb_add(&bar[XB_XSUB(b.x)], 1u);
        const unsigned gen = old / nloc;
        if (old + 1u == (gen + 1u) * nloc) {
            __builtin_amdgcn_fence(__ATOMIC_RELEASE, "agent");
            asm volatile("s_waitcnt vmcnt(0)" ::: "memory");
            const unsigned og = xb_add(&bar[XB_TOP], 1u);
            const unsigned tg = og / nx;
            if (og + 1u == (tg + 1u) * nx) xb_add(&bar[XB_TOPGEN], 1u);
            else XB_SPIN(xb_ld(&bar[XB_TOPGEN]) == tg, bar);
            __builtin_amdgcn_fence(__ATOMIC_ACQUIRE, "agent");
            xb_add(&bar[XB_XGEN(b.x)], 1u);
            asm volatile("s_waitcnt vmcnt(0)" ::: "memory");
        } else {
            XB_SPIN(xb_ld(&bar[XB_XGEN(b.x)]) == gen, bar);
            __builtin_amdgcn_fence(__ATOMIC_ACQUIRE, "agent");
            asm volatile("s_waitcnt vmcnt(0)" ::: "memory");
        }
    }
    __syncthreads();
}

using pg8::Unit; using pg8::pack8;
typedef pg8::u32x4 u32x4;

struct EpiInProj {
    static constexpr bool PERM = true;
    const float* rstd1; bf16* cb; bf16* ccx; bf16* Qb; bf16* Kb; bf16* Vb; const float* ropec; const float* ropes; const float* gq; const float* gk;
    __device__ __forceinline__ void operator()(const f32x4 (&acc)[2][2][4][2], const Unit& u, int wr, int wc, int fr, int fq) const {
        asm volatile("" : "+v"(fr), "+v"(fq));
        const int pn = __builtin_amdgcn_readfirstlane(u.pn), pm = __builtin_amdgcn_readfirstlane(u.pm); const bool meta = (pm == NTOK / 256);
#define EPI_FENCE() asm volatile("" ::: "memory")
        if (pn < 2) {
            if (!meta) {
#pragma unroll
                for (int ai = 0; ai < 2; ++ai)
#pragma unroll
                    for (int m = 0; m < 4; ++m) { const int R = pm * 256 + ai * 128 + wr * 64 + m * 16 + fr; const float rs = rstd1[R];
#pragma unroll
                        for (int bj = 0; bj < 2; ++bj) *(u32x4*)(cb + (size_t)R * CONVW + 256 * pn + 128 * bj + 32 * wc + 8 * fq) = pack8(acc[ai][bj][m][0] * rs, acc[ai][bj][m][1] * rs);
                        if (m & 1) EPI_FENCE(); } }
        } else if (pn < 6) {
#pragma unroll
            for (int ai = 0; ai < 2; ++ai)
#pragma unroll
                for (int m = 0; m < 4; ++m) { const int rl = ai * 128 + wr * 64 + m * 16 + fr, R = pm * 256 + rl; const float rs = rstd1[R]; const int b = R >> 13, i = R & (SEQ - 1);
                    const u32x4 w = pack8((acc[ai][0][m][0] * rs) * (acc[ai][1][m][0] * rs), (acc[ai][0][m][1] * rs) * (acc[ai][1][m][1] * rs));
                    const int col = 128 * (pn - 2) + 32 * wc + 8 * fq;
                    if (!meta) *(u32x4*)(ccx + ((size_t)(b * CCXROWS + 2 + i)) * CONVW + col) = w;
                    else if (rl == 14 || rl == 15) {
#pragma unroll
                        for (int bb = 0; bb < BATCH; ++bb) *(u32x4*)(ccx + ((size_t)(bb * CCXROWS + rl - 14)) * CONVW + col) = w; }
                    if (m & 1) EPI_FENCE(); }
        } else if (pn < 10) {
            const bool isq = pn < 8; const float* g = isq ? gq : gk;
            const int hm = 4 * ((pn - 6) & 1) + wc, head = hm >> 1, mp = hm & 1;
#pragma unroll
            for (int ai = 0; ai < 2; ++ai)
#pragma unroll
                for (int m = 0; m < 4; ++m) {
                    const int rl = ai * 128 + wr * 64 + m * 16 + fr, R = pm * 256 + rl; const float rs = rstd1[R]; const int b = R >> 13, i = R & (SEQ - 1);
                    f32x4 y[2][2]; float ss = 0.f;
#pragma unroll
                    for (int bj = 0; bj < 2; ++bj)
#pragma unroll
                        for (int n = 0; n < 2; ++n) { y[bj][n] = acc[ai][bj][m][n] * rs; const f32x4 q = y[bj][n] * y[bj][n]; ss += (q[0] + q[1]) + (q[2] + q[3]); }
                    ss += __shfl_xor(ss, 16); ss += __shfl_xor(ss, 32);
                    const float r = rsqrtf(ss * (1.0f / 64.0f) + EPS) * (isq ? QSCALE : 1.0f);
#pragma unroll
                    for (int bj = 0; bj < 2; ++bj)
#pragma unroll
                        for (int n = 0; n < 2; ++n) y[bj][n] = y[bj][n] * r * *(const f32x4*)(g + qk_delta(4 * bj + fq, 4 * n));
                    const int pos = meta ? (rl & 15) : NMETA + i;
                    if (fq < 2) {
                        const f32x4 c = *(const f32x4*)(ropec + pos * 8 + 4 * fq), s = *(const f32x4*)(ropes + pos * 8 + 4 * fq);
                        const f32x4 a = y[0][0], bq = y[0][1];
                        y[0][0] = a * c - bq * s; y[0][1] = bq * c + a * s;
                    }
#pragma unroll
                    for (int bj = 0; bj < 2; ++bj) { const u32x4 w = pack8(y[bj][0], y[bj][1]);
                        if (isq) { if (!meta) *(u32x4*)(Qb + q_off(b, head, mp, i, 4 * bj + fq)) = w; }
                        else if (!meta) *(u32x4*)(Kb + k_off(b, head, (i >> 6) + 1, mp, 4 * bj + fq, i & 63)) = w;
                        else if (rl < NMETA) {
#pragma unroll
                            for (int bb = 0; bb < BATCH; ++bb) *(u32x4*)(Kb + k_off(bb, head, 0, mp, 4 * bj + fq, 48 + rl)) = w; } }
                    EPI_FENCE();
                }
        } else {
#pragma unroll
            for (int ai = 0; ai < 2; ++ai)
#pragma unroll
                for (int m = 0; m < 4; ++m) { const int rl = ai * 128 + wr * 64 + m * 16 + fr, R = pm * 256 + rl; const float rs = rstd1[R]; const int b = R >> 13, i = R & (SEQ - 1);
#pragma unroll
                    for (int bj = 0; bj < 2; ++bj) { const int head = 2 * (pn - 10) + bj; const u32x4 w = pack8(acc[ai][bj][m][0] * rs, acc[ai][bj][m][1] * rs);
                        if (!meta) *(u32x4*)(Vb + v_off(b, head, (i >> 6) + 1, wc, i & 63, 8 * fq)) = w;
                        else if (rl < NMETA) {
#pragma unroll
                            for (int bb = 0; bb < BATCH; ++bb) *(u32x4*)(Vb + v_off(bb, head, 0, wc, 48 + rl, 8 * fq)) = w; } }
                    if (m & 1) EPI_FENCE(); }
        }
#undef EPI_FENCE
    }
};

struct EpiOutProj {
    static constexpr bool PERM = true;
    const float* x; float* out; bf16* hb;
    __device__ __forceinline__ void operator()(const f32x4 (&acc)[2][2][4][2], const Unit& u, int wr, int wc, int fr, int fq) const {
        asm volatile("" : "+v"(fr), "+v"(fq));
#pragma unroll
        for (int ai = 0; ai < 2; ++ai)
#pragma unroll
            for (int m = 0; m < 4; ++m) {
                const size_t R = (size_t)u.pm * 256 + ai * 128 + wr * 64 + m * 16 + fr;
#pragma unroll
                for (int bj = 0; bj < 2; ++bj) { const size_t off = R * DM + 256 * u.pn + 128 * bj + 32 * wc + 8 * fq;
                    const f32x4 h0 = *(const f32x4*)(x + off) + acc[ai][bj][m][0], h1 = *(const f32x4*)(x + off + 4) + acc[ai][bj][m][1];
                    *(f32x4*)(out + off) = h0; *(f32x4*)(out + off + 4) = h1; *(u32x4*)(hb + off) = pack8(h0, h1); }
            }
    }
};

struct MoeTab { const LAS int* blkstart; const LAS int* cnt; };

struct EpiMoe1 {
    static constexpr bool PERM = true;
    MoeTab tb; const int* rowpair; const float* rstd2; bf16* hid;
    __device__ __forceinline__ void operator()(const f32x4 (&acc)[2][2][4][2], const Unit& u, int wr, int wc, int fr, int fq) const {
        asm volatile("" : "+v"(fr), "+v"(fq));
        const int e = u.pn >> 2, ct = u.pn & 3, rb = u.pm - tb.blkstart[e], cn = tb.cnt[e];
#pragma unroll
        for (int ai = 0; ai < 2; ++ai)
#pragma unroll
            for (int m = 0; m < 4; ++m) {
                const int rl = ai * 128 + wr * 64 + m * 16 + fr, idx = rb * 256 + rl;
                if (idx < cn) {
                    const int tok = rowpair[(size_t)e * CAP + idx] >> 1; const float rs = rstd2[tok];
                    f32x4 hv[2];
#pragma unroll
                    for (int n = 0; n < 2; ++n) { const f32x4 g = acc[ai][0][m][n] * rs, up = acc[ai][1][m][n] * rs;
#pragma unroll
                        for (int j = 0; j < 4; ++j) hv[n][j] = g[j] * __builtin_amdgcn_rcpf(1.0f + __builtin_amdgcn_exp2f(-1.4426950408889634f * g[j])) * up[j]; }
                    *(u32x4*)(hid + ((size_t)u.pm * 256 + rl) * DFF + 128 * ct + 32 * wc + 8 * fq) = pack8(hv[0], hv[1]);
                }
            }
    }
};

struct EpiMoe2 {
    static constexpr bool PERM = true;
    MoeTab tb; const int* rowpair; const float* rowgate; bf16* ybuf;
    __device__ __forceinline__ void operator()(const f32x4 (&acc)[2][2][4][2], const Unit& u, int wr, int wc, int fr, int fq) const {
        asm volatile("" : "+v"(fr), "+v"(fq));
        const int e = u.pn >> 2, ct = u.pn & 3, rb = u.pm - tb.blkstart[e], cn = tb.cnt[e];
#pragma unroll
        for (int ai = 0; ai < 2; ++ai)
#pragma unroll
            for (int m = 0; m < 4; ++m) {
                const int rl = ai * 128 + wr * 64 + m * 16 + fr, idx = rb * 256 + rl;
                if (idx < cn) {
                    const int pr = rowpair[(size_t)e * CAP + idx]; const float gt = rowgate[(size_t)e * CAP + idx];
#pragma unroll
                    for (int bj = 0; bj < 2; ++bj) *(u32x4*)(ybuf + (size_t)pr * DM + 256 * ct + 128 * bj + 32 * wc + 8 * fq) = pack8(acc[ai][bj][m][0] * gt, acc[ai][bj][m][1] * gt);
                }
            }
    }
};

struct MoeOrder {
    int G, c, nunits, K; MoeTab tb; const int* rowpair;
    __device__ __forceinline__ bool next(int i, Unit& u) const {
        const int L = i * G + c; if (L >= nunits) return false;
        const int pm = L >> 2; int e = 0;
        for (int j = 1; j < NEXP; ++j) e += (tb.blkstart[j] <= pm) ? 1 : 0;
        u.pm = pm; u.pn = 4 * e + (L & 3); return true;
    }
    __device__ __forceinline__ unsigned arow_off(const Unit& u, int r) const {
        const int e = u.pn >> 2, idx = (u.pm - tb.blkstart[e]) * 256 + r;
        const int tok = idx < tb.cnt[e] ? (rowpair[(size_t)e * CAP + idx] >> 1) : 0;
        return (unsigned)tok * (unsigned)(K * 2);
    }
};

constexpr int NWAVES = 8;
constexpr int RING_OFF = 0, RING_BYTES = 131072;
constexpr int LDSCTL_OFF = RING_BYTES, MISC_OFF = LDSCTL_OFF + 320;
constexpr int TAB_OFF = LDSCTL_OFF + 1024;
constexpr int LDS_BYTES = 147456;
struct Frame {
    LAS unsigned char* lds; volatile LAS unsigned* MISC; gu32* ctl;
    int tid, lane, wave, vcu, G;
};
struct Args { const float* in[21]; float* out; unsigned char* ws; int ph_lo, ph_hi; };

__device__ __forceinline__ float wave_sum(float v) {
#pragma unroll
    for (int o = 1; o < 64; o <<= 1) v += __shfl_xor(v, o);
    return v;
}
__device__ __forceinline__ float wave_max(float v) {
#pragma unroll
    for (int o = 1; o < 64; o <<= 1) v = fmaxf(v, __shfl_xor(v, o));
    return v;
}

template <class ColPtr>
__device__ __forceinline__ void p0_transpose_item(const ColPtr& src, int ldw, int K, int N, const float* gain, bf16* WT, LAS float* scr, int item, int lane) {
    const int nblk = N / 32, kb = item / nblk, nb = item % nblk, k0 = 64 * kb, n0 = 32 * nb;
    const float* colp = src(n0 + (lane & 31));
#pragma unroll 8
    for (int i = 0; i < 32; ++i) { const int kk = 2 * i + (lane >> 5); float w = colp[(size_t)(k0 + kk) * ldw]; if (gain) w *= gain[k0 + kk]; scr[kk * 33 + (lane & 31)] = w; }
    LDS_WAIT(); asm volatile("" ::: "memory");
    const int c = lane & 7;
#pragma unroll
    for (int j = 0; j < 4; ++j) { const int n = (lane >> 3) + 8 * j; const LAS float* s = scr + (8 * c) * 33 + n;
        v4u o; o.x = pk2(s[0 * 33], s[1 * 33]); o.y = pk2(s[2 * 33], s[3 * 33]); o.z = pk2(s[4 * 33], s[5 * 33]); o.w = pk2(s[6 * 33], s[7 * 33]);
        *(GAS v4u*)(WT + (size_t)(n0 + n) * K + k0 + 8 * c) = o; }
    LDS_WAIT(); asm volatile("" ::: "memory");
}
struct ColIn { const float* w; __device__ __forceinline__ const float* operator()(int n) const { return w + inproj_col(n); } };
struct ColPlain { const float* w; __device__ __forceinline__ const float* operator()(int n) const { return w + n; } };
struct ColGU { const float* wg; long long du; __device__ __forceinline__ const float* operator()(int n) const { const int ct = n >> 8, bj = (n >> 7) & 1, x = n & 127; return wg + (bj ? du : 0ll) + 128 * ct + x; } };

__device__ __forceinline__ double rope_invfreq(int i) {
    const double t[8] = {1.0, 0.19392274474868576, 0.03760603093086393, 0.007292664737217109, 0.001414213562373095, 0.0002742481756762073, 5.318295896944988e-05, 1.031338537721246e-05};
    double r = t[0];
#pragma unroll
    for (int j = 1; j < 8; ++j) r = (i == j) ? t[j] : r;
    return r;
}

__device__ __forceinline__ void p0_prologue(Frame& F, const Args& a, unsigned char* ws) {
    LAS float* scr = (LAS float*)(F.lds + RING_OFF + F.wave * 16384);
    const int gw = F.vcu * NWAVES + F.wave, NGW = F.G * NWAVES, lane = F.lane;
    const float* x = a.in[0]; const float* meta = a.in[1]; const float* g1 = a.in[2]; const float* w_in = a.in[3];
    const float* w_out = a.in[12]; const float* g2 = a.in[13]; const float* w_rg = a.in[14]; const float* w_re = a.in[16];
    const float* w_gate = a.in[18]; const float* w_up = a.in[19]; const float* w_down = a.in[20];
    bf16* Wt_in = (bf16*)(ws + WS_WIN); bf16* Wt_out = (bf16*)(ws + WS_WOUT); bf16* Wgu = (bf16*)(ws + WS_WGU); bf16* Wd = (bf16*)(ws + WS_WD);
    constexpr int I_IN = (DM / 64) * (INCOLS / 32), I_OUT = (DM / 64) * (DM / 32), I_GU = (DM / 64) * (1024 / 32), I_D = (DFF / 64) * (DM / 32);
    constexpr int NITEMS = I_IN + I_OUT + NEXP * (I_GU + I_D);
    for (int it = gw; it < NITEMS; it += NGW) {
        int r = it;
        if (r < I_IN) { p0_transpose_item(ColIn{w_in}, INCOLS, DM, INCOLS, g1, Wt_in, scr, r, lane); continue; } r -= I_IN;
        if (r < I_OUT) { p0_transpose_item(ColPlain{w_out}, DM, DM, DM, nullptr, Wt_out, scr, r, lane); continue; } r -= I_OUT;
        if (r < NEXP * I_GU) { const int e = r / I_GU; p0_transpose_item(ColGU{w_gate + (size_t)e * DM * DFF, (long long)(w_up - w_gate)}, DFF, DM, 1024, g2, Wgu + (size_t)e * 1024 * DM, scr, r % I_GU, lane); continue; } r -= NEXP * I_GU;
        { const int e = r / I_D; p0_transpose_item(ColPlain{w_down + (size_t)e * DFF * DM}, DM, DFF, DM, nullptr, Wd + (size_t)e * DM * DFF, scr, r % I_D, lane); }
    }
    bf16* xb = (bf16*)(ws + WS_XB); float* rstd1 = (float*)(ws + WS_RSTD1);
    for (int R = gw; R < MROWS; R += NGW) {
        GAS unsigned long long* o8 = (GAS unsigned long long*)(xb + (size_t)R * DM) + lane;
        if (R >= NTOK + NMETA) {
#pragma unroll
            for (int j = 0; j < 4; ++j) o8[64 * j] = 0ull;
            if (lane == 0) rstd1[R] = 1.0f; continue; }
        const float* xrow = R < NTOK ? x + (size_t)R * DM : meta + (size_t)(R - NTOK) * DM;
        const GAS f32x4* xr = (const GAS f32x4*)xrow + lane;
        f32x4 v[4]; float s = 0.f;
#pragma unroll
        for (int j = 0; j < 4; ++j) { v[j] = xr[64 * j]; s += (v[j].x * v[j].x + v[j].y * v[j].y) + (v[j].z * v[j].z + v[j].w * v[j].w); }
        s = wave_sum(s);
        if (lane == 0) rstd1[R] = rsqrtf(s * (1.0f / DM) + EPS);
#pragma unroll
        for (int j = 0; j < 4; ++j) o8[64 * j] = (unsigned long long)pk2(v[j].x, v[j].y) | ((unsigned long long)pk2(v[j].z, v[j].w) << 32);
    }
    const int gt = F.vcu * (NWAVES * 64) + F.tid, NGT = F.G * NWAVES * 64;
    float* ropec = (float*)(ws + WS_ROPEC); float* ropes = (float*)(ws + WS_ROPES);
    for (int it = gt; it < (SEQ + NMETA) * 8; it += NGT) { const int pos = it >> 3, i = it & 7;
        const double rev = (double)pos * rope_invfreq(i) * 0.15915494309189535; const float fr = (float)(rev - __builtin_rint(rev));
        ropec[it] = __builtin_amdgcn_cosf(fr); ropes[it] = __builtin_amdgcn_sinf(fr); }
    float* wr = (float*)(ws + WS_WR);
    for (int it = gt; it < 36 * DM; it += NGT) { const int j = it >> 10, k = it & 1023; wr[it] = g2[k] * (j < 4 ? w_rg[k * NGRP + j] : w_re[k * NEXP + (j - 4)]); }
    bf16* Kb = (bf16*)(ws + WS_K); bf16* Vb = (bf16*)(ws + WS_V);
    for (int it = gt; it < BATCH * NHEAD * 16 * 48; it += NGT) { const int bh = it / (16 * 48), r2 = it % (16 * 48), mc = r2 / 48, row = r2 % 48;
        *(GAS v4u*)(Kb + k_off(bh >> 2, bh & 3, 0, mc >> 3, mc & 7, row)) = (v4u){0u, 0u, 0u, 0u}; }
    for (int it = gt; it < BATCH * NHEAD * 4 * 48 * 4; it += NGT) { const int bh = it / (4 * 48 * 4), r2 = it % (4 * 48 * 4), dq = r2 / (48 * 4), r3 = r2 % (48 * 4), row = r3 >> 2, c8 = (r3 & 3) * 8;
        *(GAS v4u*)(Vb + v_off(bh >> 2, bh & 3, 0, dq, row, c8)) = (v4u){0u, 0u, 0u, 0u}; }
}

__device__ __forceinline__ float bf2f(unsigned short v) { return __builtin_bit_cast(float, (unsigned)v << 16); }
__device__ __forceinline__ void conv_pass(Frame& F, const Args& a, unsigned char* ws) {
    const bf16* cb = (const bf16*)(ws + WS_CB); const bf16* ccx = (const bf16*)(ws + WS_CCX); bf16* mix = (bf16*)(ws + WS_MIX); const float* cw = a.in[4];
    const int gt = F.vcu * (NWAVES * 64) + F.tid, NGT = F.G * NWAVES * 64;
    for (int it = gt; it < NTOK * (CONVW / 8); it += NGT) {
        const int R = it >> 6, c0 = (it & 63) * 8, b = R >> 13, i = R & (SEQ - 1);
        const bf16* z = ccx + ((size_t)(b * CCXROWS + i)) * CONVW + c0;
        const v4u z0 = *(const GAS v4u*)z, z1 = *(const GAS v4u*)(z + CONVW), z2 = *(const GAS v4u*)(z + 2 * CONVW), cbv = *(const GAS v4u*)(cb + (size_t)R * CONVW + c0);
        float o[8];
#pragma unroll
        for (int j = 0; j < 8; ++j) { const int sh = (j & 1) * 16; const int q = j >> 1;
            const float a0 = __builtin_bit_cast(float, ((z0[q] >> sh) & 0xffffu) << 16), a1 = __builtin_bit_cast(float, ((z1[q] >> sh) & 0xffffu) << 16), a2 = __builtin_bit_cast(float, ((z2[q] >> sh) & 0xffffu) << 16);
            const float cbf = __builtin_bit_cast(float, ((cbv[q] >> sh) & 0xffffu) << 16);
            o[j] = cbf * (cw[c0 + j] * a0 + cw[CONVW + c0 + j] * a1 + cw[2 * CONVW + c0 + j] * a2); }
        v4u w; w.x = pk2(o[0], o[1]); w.y = pk2(o[2], o[3]); w.z = pk2(o[4], o[5]); w.w = pk2(o[6], o[7]);
        *(GAS v4u*)(mix + (size_t)R * DM + c0) = w;
    }
}

namespace att {
__device__ __forceinline__ int crow(int r, int hi) { return (r & 3) + 8 * (r >> 2) + 4 * hi; }
typedef short v4i16_t __attribute__((ext_vector_type(4)));
__device__ __forceinline__ s16x4 vtr(const LAS unsigned char* p) { return __builtin_bit_cast(s16x4, __builtin_amdgcn_ds_read_tr16_b64_v4i16((LAS v4i16_t*)p)); }
__device__ __forceinline__ unsigned cvtpk(float lo, float hi) { typedef float f2 __attribute__((ext_vector_type(2))); typedef __bf16 b2 __attribute__((ext_vector_type(2))); f2 v = {lo, hi}; b2 b = __builtin_convertvector(v, b2); return __builtin_bit_cast(unsigned, b); }

struct Par { const bf16* Qb; const bf16* Kb; const bf16* Vb; bf16* mix; const float* subg; float negM, lam; };

__device__ __forceinline__ void attn_unit(LAS unsigned char* lds, const Par& P, int b, int head, int qb) {
    const int tid = threadIdx.x, lane = tid & 63, wid = __builtin_amdgcn_readfirstlane(tid >> 6), r32 = lane & 31, hi = lane >> 5, rg = wid >> 1, mp = wid & 1;
    const int i0 = qb * 128, iq = i0 + 32 * rg + r32;
    bf16x8 qf[4];
#pragma unroll
    for (int d0 = 0; d0 < 4; ++d0) qf[d0] = *(const GAS bf16x8*)(P.Qb + q_off(b, head, mp, i0 + 32 * rg, 2 * d0 + hi) + r32 * 8);
    f32x16 o[4];
#pragma unroll
    for (int d = 0; d < 4; ++d)
#pragma unroll
        for (int r = 0; r < 16; ++r) o[d][r] = 0.f;
    float lsum = 0.f;
    const int ntl = 2 * qb + 3, mylast = 2 * qb + 1 + (rg >= 2 ? 1 : 0);
    const GAS unsigned char* kg = (const GAS unsigned char*)(P.Kb + k_off(b, head, 0, 0, 0, 0)) + tid * 16;
    const GAS unsigned char* vg = (const GAS unsigned char*)(P.Vb + v_off(b, head, 0, 0, 0, 0)) + tid * 16;
    v4u st[4];
    st[0] = *(const GAS v4u*)kg; st[1] = *(const GAS v4u*)(kg + 8192); st[2] = *(const GAS v4u*)vg; st[3] = *(const GAS v4u*)(vg + 8192);
    for (int t = 0; t < ntl; ++t) {
        LAS unsigned char* buf = lds + (t & 1) * 32768;
        *(LAS v4u*)(buf + tid * 16) = st[0]; *(LAS v4u*)(buf + 8192 + tid * 16) = st[1]; *(LAS v4u*)(buf + 16384 + tid * 16) = st[2]; *(LAS v4u*)(buf + 24576 + tid * 16) = st[3];
        if (t + 1 < ntl) { const size_t o2 = (size_t)(t + 1) * 16384;
            st[0] = *(const GAS v4u*)(kg + o2); st[1] = *(const GAS v4u*)(kg + o2 + 8192); st[2] = *(const GAS v4u*)(vg + o2); st[3] = *(const GAS v4u*)(vg + o2 + 8192); }
        __syncthreads();
        if (t <= mylast) {
            const LAS unsigned char* kb = buf + mp * 8192 + hi * 1024 + r32 * 16;
            f32x16 p0, p1;
#pragma unroll
            for (int r = 0; r < 16; ++r) { p0[r] = P.negM; p1[r] = P.negM; }
#pragma unroll
            for (int d0 = 0; d0 < 4; ++d0) {
                const bf16x8 a0 = *(const LAS bf16x8*)(kb + d0 * 2048), a1 = *(const LAS bf16x8*)(kb + d0 * 2048 + 512);
                p0 = __builtin_amdgcn_mfma_f32_32x32x16_bf16(a0, qf[d0], p0, 0, 0, 0);
                p1 = __builtin_amdgcn_mfma_f32_32x32x16_bf16(a1, qf[d0], p1, 0, 0, 0);
            }
            if (t == 0) {
#pragma unroll
                for (int r = 0; r < 16; ++r) { p0[r] = -INFINITY; if (crow(r, hi) < 16) p1[r] = -INFINITY; }
            } else if (t >= 2 * qb + 1) {
                const int lim = iq - 64 * (t - 1);
#pragma unroll
                for (int r = 0; r < 16; ++r) { if (crow(r, hi) > lim) p0[r] = -INFINITY; if (crow(r, hi) + 32 > lim) p1[r] = -INFINITY; }
            }
            float sa = 0.f;
#pragma unroll
            for (int r = 0; r < 16; ++r) { p0[r] = __builtin_amdgcn_exp2f(p0[r]); p1[r] = __builtin_amdgcn_exp2f(p1[r]); sa += p0[r] + p1[r]; }
            lsum += sa;
            bf16x8 pw[4];
            { v4u w;
              w.x = cvtpk(p0[0], p0[1]); w.y = cvtpk(p0[2], p0[3]); w.z = cvtpk(p0[4], p0[5]); w.w = cvtpk(p0[6], p0[7]); pw[0] = __builtin_bit_cast(bf16x8, w);
              w.x = cvtpk(p0[8], p0[9]); w.y = cvtpk(p0[10], p0[11]); w.z = cvtpk(p0[12], p0[13]); w.w = cvtpk(p0[14], p0[15]); pw[1] = __builtin_bit_cast(bf16x8, w);
              w.x = cvtpk(p1[0], p1[1]); w.y = cvtpk(p1[2], p1[3]); w.z = cvtpk(p1[4], p1[5]); w.w = cvtpk(p1[6], p1[7]); pw[2] = __builtin_bit_cast(bf16x8, w);
              w.x = cvtpk(p1[8], p1[9]); w.y = cvtpk(p1[10], p1[11]); w.z = cvtpk(p1[12], p1[13]); w.w = cvtpk(p1[14], p1[15]); pw[3] = __builtin_bit_cast(bf16x8, w); }
            const LAS unsigned char* vb = buf + 16384 + ((lane >> 4) & 1) * 32 + (lane & 3) * 8 + (4 * hi + ((lane & 15) >> 2)) * 64;
#pragma unroll
            for (int db = 0; db < 4; ++db)
#pragma unroll
                for (int ks = 0; ks < 4; ++ks) {
                    const s16x4 lo = vtr(vb + db * 4096 + ks * 1024), hh = vtr(vb + db * 4096 + ks * 1024 + 512);
                    const bf16x8 vf = (bf16x8){lo[0], lo[1], lo[2], lo[3], hh[0], hh[1], hh[2], hh[3]};
                    o[db] = __builtin_amdgcn_mfma_f32_32x32x16_bf16(pw[ks], vf, o[db], 0, 0, 0);
                }
        }
    }
    { auto rr = __builtin_amdgcn_permlane32_swap(__float_as_uint(lsum), __float_as_uint(lsum), false, false); lsum = __uint_as_float(rr[0]) + __uint_as_float(rr[1]); }
    __syncthreads();
    LAS float* lsc = (LAS float*)(lds + 65536) + wid * 32;
    LAS float* comb = (LAS float*)lds + rg * 4096;
    if (hi == 0) lsc[r32] = lsum;
    LDS_WAIT(); asm volatile("" ::: "memory");
    const float sc = mp ? P.lam : 1.0f;
#pragma unroll
    for (int r = 0; r < 16; ++r) { const float rl = sc / lsc[crow(r, hi)];
#pragma unroll
        for (int db = 0; db < 4; ++db) o[db][r] *= rl; }
    if (mp == 1) {
#pragma unroll
        for (int r = 0; r < 16; ++r)
#pragma unroll
            for (int db = 0; db < 4; ++db) comb[crow(r, hi) * 128 + 32 * db + r32] = o[db][r];
    }
    __syncthreads();
    if (mp == 0) {
        float ss[16];
#pragma unroll
        for (int r = 0; r < 16; ++r) { float s = 0.f;
#pragma unroll
            for (int db = 0; db < 4; ++db) { o[db][r] -= comb[crow(r, hi) * 128 + 32 * db + r32]; s += o[db][r] * o[db][r]; }
            ss[r] = s; }
#pragma unroll
        for (int r = 0; r < 16; ++r) {
#pragma unroll
            for (int off = 1; off < 32; off <<= 1) ss[r] += __shfl_xor(ss[r], off);
            ss[r] = rsqrtf(ss[r] * (1.0f / 128.0f) + EPS) * 0.8f; }
        float sg[4];
#pragma unroll
        for (int db = 0; db < 4; ++db) sg[db] = P.subg[32 * db + r32];
        bf16* orow = P.mix + ((size_t)(b * SEQ + i0 + 32 * rg)) * DM + 512 + head * 128 + r32;
#pragma unroll
        for (int r = 0; r < 16; ++r)
#pragma unroll
            for (int db = 0; db < 4; ++db) orow[(size_t)crow(r, hi) * DM + 32 * db] = (bf16)f2bf(o[db][r] * ss[r] * sg[db]);
    }
    __syncthreads();
}

__device__ __forceinline__ void attn_phase(Frame& F, const Args& a, unsigned char* ws) {
    const float* gq = a.in[5]; const float* gk = a.in[6];
    const float d1 = wave_sum(a.in[7][F.lane] * a.in[8][F.lane]), d2 = wave_sum(a.in[9][F.lane] * a.in[10][F.lane]);
    const float lam = __expf(d1) - __expf(d2) + 0.2f;
    const float mq = wave_max(fabsf(gq[F.lane])), mk = wave_max(fabsf(gk[F.lane]));
    Par P; P.Qb = (const bf16*)(ws + WS_Q); P.Kb = (const bf16*)(ws + WS_K); P.Vb = (const bf16*)(ws + WS_V); P.mix = (bf16*)(ws + WS_MIX); P.subg = a.in[11];
    P.negM = -(8.0f * mq * mk * 1.4426950408889634f); P.lam = lam;
    if (F.G == 256) {
        const int bh = F.vcu >> 4, s = F.vcu & 15;
        for (int k = 0; k < 4; ++k) { const int qb = (k == 0) ? s : (k == 1) ? 31 - s : (k == 2) ? 32 + s : 63 - s; attn_unit(F.lds, P, bh >> 2, bh & 3, qb); }
    } else {
        for (int uix = F.vcu; uix < 1024; uix += F.G) attn_unit(F.lds, P, (uix >> 6) >> 2, (uix >> 6) & 3, uix & 63);
    }
}
}

__device__ __forceinline__ void router_phase(Frame& F, const Args& a, unsigned char* ws) {
    const float* h = a.out; const float* wr = (const float*)(ws + WS_WR); float* rstd2 = (float*)(ws + WS_RSTD2);
    const float* b_rg = a.in[15]; const float* b_re = a.in[17];
    int* rowpair = (int*)(ws + WS_ROWPAIR); float* rowgate = (float*)(ws + WS_ROWGATE); unsigned* cnt = (unsigned*)(F.ctl + CW_CNT);
    LAS float* lg = (LAS float*)(F.lds + 0) + F.wave * 64;
    LAS int* pe = (LAS int*)(F.lds + 4096);
    LAS float* pg = (LAS float*)(F.lds + 8192);
    LAS int* prk = (LAS int*)(F.lds + 12288);
    LAS int* hist = (LAS int*)(F.lds + 16384);
    const int lane = F.lane;
    for (int blk = F.vcu; blk < NTOK / 128; blk += F.G) {
        if (F.tid < 64) hist[F.tid] = 0;
        __syncthreads();
        for (int tt = 0; tt < 16; ++tt) {
            const int tl = F.wave * 16 + tt, tok = blk * 128 + tl;
            const GAS f32x4* hr = (const GAS f32x4*)(h + (size_t)tok * DM) + lane;
            f32x4 v[4]; float s = 0.f;
#pragma unroll
            for (int j = 0; j < 4; ++j) { v[j] = hr[64 * j]; s += (v[j].x * v[j].x + v[j].y * v[j].y) + (v[j].z * v[j].z + v[j].w * v[j].w); }
            const float rs = rsqrtf(wave_sum(s) * (1.0f / DM) + EPS);
            float mine = 0.f;
            for (int j = 0; j < 36; ++j) {
                const GAS f32x4* wv = (const GAS f32x4*)(wr + (size_t)j * DM) + lane; float d = 0.f;
#pragma unroll
                for (int q = 0; q < 4; ++q) { const f32x4 w = wv[64 * q]; d += (v[q].x * w.x + v[q].y * w.y) + (v[q].z * w.z + v[q].w * w.w); }
                d = wave_sum(d);
                if (lane == j) mine = d * rs + (j < 4 ? b_rg[j] : b_re[j - 4]);
            }
            if (lane < 36) lg[lane] = mine;
            LDS_WAIT(); asm volatile("" ::: "memory");
            if (lane == 0) {
                rstd2[tok] = rs;
                int gi = 0; float gm = lg[0];
                for (int j = 1; j < 4; ++j) if (lg[j] > gm) { gm = lg[j]; gi = j; }
                float gs = 0.f; for (int j = 0; j < 4; ++j) gs += __expf(lg[j] - gm);
                const float gval = 1.0f / gs;
                int e1 = 0; float m1 = lg[4 + gi * 8];
                for (int j = 1; j < 8; ++j) { const float x = lg[4 + gi * 8 + j]; if (x > m1) { m1 = x; e1 = j; } }
                int e2 = -1; float m2 = -INFINITY;
                for (int j = 0; j < 8; ++j) { const float x = lg[4 + gi * 8 + j]; if (j != e1 && x > m2) { m2 = x; e2 = j; } }
                const float r = __expf(m2 - m1), g1v = gval / (1.0f + r), g2v = gval * r / (1.0f + r);
                pe[2 * tl] = gi * 8 + e1; pg[2 * tl] = g1v; pe[2 * tl + 1] = gi * 8 + e2; pg[2 * tl + 1] = g2v;
            }
            LDS_WAIT(); asm volatile("" ::: "memory");
        }
        __syncthreads();
        if (F.tid < 256) prk[F.tid] = atomicAdd((int*)&hist[pe[F.tid]], 1);
        __syncthreads();
        if (F.tid < 32) hist[32 + F.tid] = (int)__hip_atomic_fetch_add(cnt + 16 * F.tid, (unsigned)hist[F.tid], __ATOMIC_RELAXED, __HIP_MEMORY_SCOPE_AGENT);
        __syncthreads();
        if (F.tid < 256) { const int e = pe[F.tid], pos = hist[32 + e] + prk[F.tid];
            rowpair[(size_t)e * CAP + pos] = 2 * (blk * 128 + (F.tid >> 1)) + (F.tid & 1); rowgate[(size_t)e * CAP + pos] = pg[F.tid]; }
        __syncthreads();
    }
}

__device__ __forceinline__ MoeTab moe_tables(Frame& F) {
    LAS int* bs = (LAS int*)(F.lds + TAB_OFF); LAS int* cn = (LAS int*)(F.lds + TAB_OFF + 256);
    __syncthreads();
    if (F.tid < 32) cn[F.tid] = (int)__hip_atomic_load(F.ctl + CW_CNT + 16 * F.tid, RLX_AGENT);
    __syncthreads();
    if (F.tid == 0) { int s = 0; for (int e = 0; e < NEXP; ++e) { bs[e] = s; s += (cn[e] + 255) >> 8; } bs[NEXP] = s; }
    __syncthreads();
    MoeTab t; t.blkstart = bs; t.cnt = cn; return t;
}

__device__ __forceinline__ void combine_pass(Frame& F, const Args& a, unsigned char* ws) {
    float* out = a.out; const bf16* y = (const bf16*)(ws + WS_Y);
    const int gt = F.vcu * (NWAVES * 64) + F.tid, NGT = F.G * NWAVES * 64;
    for (int it = gt; it < NTOK * (DM / 8); it += NGT) {
        const size_t tok = (size_t)(it >> 7); const int c0 = (it & 127) * 8;
        const v4u y0 = *(const GAS v4u*)(y + (2 * tok) * DM + c0), y1 = *(const GAS v4u*)(y + (2 * tok + 1) * DM + c0);
        GAS f32x4* op = (GAS f32x4*)(out + tok * DM + c0);
        f32x4 h0 = op[0], h1 = op[1];
#pragma unroll
        for (int q = 0; q < 4; ++q) { const float lo = __builtin_bit_cast(float, y0[q] << 16) + __builtin_bit_cast(float, y1[q] << 16), hi2 = __builtin_bit_cast(float, y0[q] & 0xffff0000u) + __builtin_bit_cast(float, y1[q] & 0xffff0000u);
            if (q < 2) { h0[2 * q] += lo; h0[2 * q + 1] += hi2; } else { h1[2 * (q - 2)] += lo; h1[2 * (q - 2) + 1] += hi2; } }
        op[0] = h0; op[1] = h1;
    }
}

constexpr int N_PHASES = 8;
#ifndef MK_SPLIT
#define MK_SPLIT 1
#endif
__global__ void __launch_bounds__(NWAVES * 64, 2) hymba_fwd(Args args) {
    extern __shared__ __attribute__((aligned(16))) unsigned char lds[];
    Frame F;
    F.lds = (LAS unsigned char*)lds;
    F.MISC = (volatile LAS unsigned*)(F.lds + MISC_OFF);
    F.tid = threadIdx.x; F.lane = F.tid & 63; F.wave = __builtin_amdgcn_readfirstlane(F.tid >> 6);
    F.G = gridDim.x; { const int bx = blockIdx.x; F.vcu = (F.G % 8 == 0) ? (bx % 8) * (F.G / 8) + bx / 8 : bx; }
    unsigned char* ws = args.ws;
    F.ctl = (gu32*)(ws + WS_CTL);
    for (int u = F.tid; u < (LDS_BYTES - LDSCTL_OFF) / 4; u += NWAVES * 64) ((LAS unsigned*)(F.lds + LDSCTL_OFF))[u] = 0u;
    __syncthreads();
    const int lo = args.ph_lo, hi = args.ph_hi;
    XcdBarrier bar; bar.bar = (unsigned*)(F.ctl + CW_BAR); bar.x = 0; bar.st = nullptr;
    if (hi - lo > 1) bar = xcd_barrier_post((unsigned*)(F.ctl + CW_BAR), F.MISC + 8);
#ifndef PHASE_MASK
#define PHASE_MASK 0xff
#endif
#define IN(k) (((PHASE_MASK >> (k)) & 1) && lo <= (k) && (k) < hi)
#define SEAM(k) do { if (IN(k) && IN((k) + 1)) xcd_barrier(bar); } while (0)

    if (IN(0)) { p0_prologue(F, args, ws); SEAM(0); }

    if (IN(1)) {
        pg8::Gemm g{(const bf16*)(ws + WS_XB), (const bf16*)(ws + WS_WIN), MROWS, INCOLS, DM}; pg8::StaticOrder S; S.init(MROWS, INCOLS, F.G, (int)blockIdx.x);
        EpiInProj E{(const float*)(ws + WS_RSTD1), (bf16*)(ws + WS_CB), (bf16*)(ws + WS_CCX), (bf16*)(ws + WS_Q), (bf16*)(ws + WS_K), (bf16*)(ws + WS_V),
                    (const float*)(ws + WS_ROPEC), (const float*)(ws + WS_ROPES), args.in[5], args.in[6]};
        pg8::gemm_phase<EpiInProj, pg8::StaticOrder, true, false>(F.lds + RING_OFF, g, S, E);
        SEAM(1);
    }

    if (IN(2)) { conv_pass(F, args, ws); att::attn_phase(F, args, ws); SEAM(2); }

    if (IN(3)) {
        pg8::Gemm g{(const bf16*)(ws + WS_MIX), (const bf16*)(ws + WS_WOUT), NTOK, DM, DM}; pg8::StaticOrder S; S.init(NTOK, DM, F.G, (int)blockIdx.x);
        EpiOutProj E{args.in[0], args.out, (bf16*)(ws + WS_XB)};
        pg8::gemm_phase<EpiOutProj, pg8::StaticOrder, true, false>(F.lds + RING_OFF, g, S, E);
        SEAM(3);
    }

    if (IN(4)) { router_phase(F, args, ws); SEAM(4); }

    if (IN(5)) {
        const MoeTab tb = moe_tables(F);
        MoeOrder S{F.G, (int)blockIdx.x, 4 * tb.blkstart[NEXP], DM, tb, (const int*)(ws + WS_ROWPAIR)};
        pg8::Gemm g{(const bf16*)(ws + WS_XB), (const bf16*)(ws + WS_WGU), 0, NEXP * 1024, DM};
        EpiMoe1 E{tb, (const int*)(ws + WS_ROWPAIR), (const float*)(ws + WS_RSTD2), (bf16*)(ws + WS_HID)};
        pg8::gemm_phase<EpiMoe1, MoeOrder, true, true>(F.lds + RING_OFF, g, S, E);
        SEAM(5);
    }

    if (IN(6)) {
        const MoeTab tb = moe_tables(F);
        MoeOrder S{F.G, (int)blockIdx.x, 4 * tb.blkstart[NEXP], DFF, tb, (const int*)(ws + WS_ROWPAIR)};
        pg8::Gemm g{(const bf16*)(ws + WS_HID), (const bf16*)(ws + WS_WD), 0, NEXP * DM, DFF};
        EpiMoe2 E{tb, (const int*)(ws + WS_ROWPAIR), (const float*)(ws + WS_ROWGATE), (bf16*)(ws + WS_Y)};
        pg8::gemm_phase<EpiMoe2, MoeOrder, true, false>(F.lds + RING_OFF, g, S, E);
        SEAM(6);
    }

    if (IN(7)) combine_pass(F, args, ws);
#undef IN
#undef SEAM
}

extern "C" void kernel_launch(void* const* d_in, const int* in_sizes, int n_in, void* d_out, int out_size, void* d_ws, size_t ws_size, hipStream_t stream) {
    static int grid = 0;
    if (grid == 0) {
        if (n_in != 21 || in_sizes[0] != NTOK * DM || out_size != NTOK * DM || ws_size < WS_END) { fprintf(stderr, "kernel_launch: unexpected shapes (n_in %d, in0 %d, out %d, ws %zu)\n", n_in, n_in > 0 ? in_sizes[0] : -1, out_size, ws_size); grid = -1; return; }
        int dev = 0, cus = 0, per_cu = 0;
        if (hipGetDevice(&dev) != hipSuccess || hipDeviceGetAttribute(&cus, hipDeviceAttributeMultiprocessorCount, dev) != hipSuccess) { grid = -1; return; }
        if (hipFuncSetAttribute((const void*)hymba_fwd, hipFuncAttributeMaxDynamicSharedMemorySize, LDS_BYTES) != hipSuccess) { fprintf(stderr, "kernel_launch: hipFuncSetAttribute failed\n"); grid = -1; return; }
        if (hipOccupancyMaxActiveBlocksPerMultiprocessor(&per_cu, (const void*)hymba_fwd, NWAVES * 64, LDS_BYTES) != hipSuccess || per_cu < 1) { fprintf(stderr, "kernel_launch: occupancy query says %d\n", per_cu); (void)hipGetLastError(); grid = -1; return; }
        grid = cus;
    }
    if (grid < 0) return;
    if (hipMemsetAsync((char*)d_ws + WS_CTL, 0, CTL_ZERO_BYTES, stream) != hipSuccess) return;
    Args a{};
    for (int i = 0; i < 21; ++i) a.in[i] = (const float*)d_in[i];
    a.out = (float*)d_out; a.ws = (unsigned char*)d_ws;
#if MK_SPLIT
    for (int p = 0; p < N_PHASES; ++p) { a.ph_lo = p; a.ph_hi = p + 1; hipLaunchKernelGGL(hymba_fwd, dim3(grid), dim3(NWAVES * 64), LDS_BYTES, stream, a); }
#else
    a.ph_lo = 0; a.ph_hi = N_PHASES;
    hipLaunchKernelGGL(hymba_fwd, dim3(grid), dim3(NWAVES * 64), LDS_BYTES, stream, a);
#endif
}
```

```cpp
#include <hip/hip_runtime.h>
#include <cstdio>
#include <cstdint>
#include <cmath>

#define HD_INL __host__ __device__ __forceinline__
#define GAS __attribute__((address_space(1)))
#define LAS __attribute__((address_space(3)))
typedef unsigned short bf16;
typedef unsigned v4u __attribute__((ext_vector_type(4)));
typedef float f32x4 __attribute__((ext_vector_type(4)));
typedef float f32x16 __attribute__((ext_vector_type(16)));
typedef short bf16x8 __attribute__((ext_vector_type(8)));
typedef short s16x4 __attribute__((ext_vector_type(4)));
typedef GAS unsigned gu32;
#define RLX_AGENT __ATOMIC_RELAXED, __HIP_MEMORY_SCOPE_AGENT
#define LDS_WAIT() asm volatile("s_waitcnt lgkmcnt(0)" ::: "memory")
#define VM_WAIT() asm volatile("s_waitcnt vmcnt(0)" ::: "memory")

constexpr int DM = 1024, BATCH = 4, SEQ = 8192, NMETA = 16;
constexpr int NTOK = BATCH * SEQ;
constexpr int MROWS = NTOK + 256;
constexpr int CONVW = 512, NHEAD = 4, HDIM = 64, VDIM = 128, INCOLS = 3072;
constexpr int NEXP = 32, DFF = 512, NGRP = 4, EPG = 8;
constexpr int KVT = SEQ / 64 + 1;
constexpr int CCXROWS = SEQ + 2;
constexpr int CAP = NTOK;
constexpr float EPS = 1e-6f;
constexpr float QSCALE = 0.125f * 1.4426950408889634f;

constexpr size_t MiB = 1u << 20;
constexpr size_t WS_CTL = 0, CTL_ZERO_BYTES = 128 * 1024;
constexpr size_t WS_RSTD1 = 1 * MiB, WS_RSTD2 = 1 * MiB + 512 * 1024, WS_ROPEC = 2 * MiB, WS_ROPES = 2 * MiB + 512 * 1024, WS_WR = 3 * MiB, WS_MISCF = 3 * MiB + 512 * 1024;
constexpr size_t WS_WIN = 4 * MiB, WS_WOUT = 10 * MiB, WS_WGU = 12 * MiB  , WS_HQ = 44 * MiB  , WS_WD = 76 * MiB  ;
constexpr float F8S_H = 8.0f, F8S_W = 256.0f, F8S_HID = 4.0f;
constexpr size_t WS_ROWPAIR = 108 * MiB, WS_ROWRS = 112 * MiB;
constexpr size_t WS_XB = 116 * MiB;
constexpr size_t WS_MIX = 181 * MiB;
constexpr size_t WS_Y = 342 * MiB;
constexpr size_t WS_CB = 245 * MiB, WS_CCX = 277 * MiB, WS_Q = 310 * MiB;
constexpr size_t WS_HID = 245 * MiB;
constexpr size_t WS_K = 342 * MiB, WS_V = 375 * MiB, WS_END = 408 * MiB  , WS_NEED = 472 * MiB;
static_assert(WS_XB + (size_t)MROWS * DM * 2 <= WS_MIX && WS_Y + (size_t)2 * NTOK * DM * 2 <= WS_NEED && WS_Y >= WS_HID + (size_t)288 * 256 * DFF * 2 && WS_HID + (size_t)288 * 256 * DFF * 2 <= WS_K, "ws map");
static_assert(WS_WGU + (size_t)NEXP * 1024 * DM <= WS_HQ && WS_HQ + (size_t)NTOK * DM <= WS_WD && WS_WD + (size_t)NEXP * DM * DFF <= WS_ROWPAIR, "ws map 3");
static_assert(WS_CCX + (size_t)BATCH * CCXROWS * CONVW * 2 <= WS_Q && WS_K + (size_t)BATCH * NHEAD * KVT * 16384 <= WS_V && WS_V + (size_t)BATCH * NHEAD * KVT * 16384 <= WS_END, "ws map 2");
constexpr int CW_TMO = 0, CW_CODE = 1, CW_ERR = 16  , CW_BAR = 4096, CW_CNT = 16384  , CW_RDY = 20480  ;

HD_INL int qk_delta(int chunk, int e) { const int bj = chunk >> 2, fq = chunk & 3; if (bj == 0 && fq < 2) return e < 4 ? 4 * fq + e : 8 + 4 * fq + (e - 4); return bj == 0 ? 8 * fq + e : 32 + 8 * fq + e; }
HD_INL size_t q_off(int b, int head, int mp, int i, int chunk) { return ((((size_t)(b * 4 + head) * 2 + mp) * 256 + (i >> 5)) * 8 + chunk) * 256 + (size_t)(i & 31) * 8; }
HD_INL size_t k_off(int b, int head, int t, int mp, int chunk, int row) { return (((size_t)(b * 4 + head) * KVT + t) * 2 + mp) * 4096 + (size_t)chunk * 512 + (size_t)row * 8; }
HD_INL size_t v_off(int b, int head, int t, int dq, int row, int dcol) { return ((size_t)(b * 4 + head) * KVT + t) * 8192 + (size_t)dq * 2048 + (size_t)(row >> 4) * 512 + (size_t)(row & 15) * 32 + dcol; }
HD_INL int inproj_col(int n) {
    const int pn = n >> 8, p = n & 255, bj = p >> 7, x = p & 127;
    if (pn < 2 || pn >= 10) return n;
    if (pn < 6) return (bj ? 1024 : 512) + 128 * (pn - 2) + x;
    const int wc = x >> 5, fq = (x >> 3) & 3, e = x & 7;
    return 1536 + 256 * (pn - 6) + 64 * wc + qk_delta(4 * bj + fq, e);
}

namespace pg8 {
#define PG8_LAS __attribute__((address_space(3)))
typedef unsigned short bf16_t;
typedef unsigned u32x4 __attribute__((ext_vector_type(4)));
typedef int i32x4 __attribute__((ext_vector_type(4)));
typedef int i32x8 __attribute__((ext_vector_type(8)));
constexpr int BM = 256, BK = 64, HALF = 128, HTB = HALF * BK * 2  , STAGE_BYTES = 8 * HTB, NXCD = 8, WGM = 8;

__host__ __device__ __forceinline__ int lds_byte(int r, int c) { const int st = (r >> 4) * 2 + (c >> 5), rr = r & 15, cc = c & 31, ob = rr * 64 + cc * 2; return st * 1024 + (ob ^ (((ob >> 9) & 1) << 5)); }
__host__ __device__ __forceinline__ void stage_rc(int b, int& R, int& C) { const int st = b / 1024, sb = b % 1024, swz = sb ^ (((sb >> 9) & 1) << 5); R = (st >> 1) * 16 + swz / 64; C = (st & 1) * 32 + (swz % 64) / 2; }
__host__ __device__ __forceinline__ int perm32(int rho) { const int n = rho >> 4, i = rho & 15; return 8 * (i >> 2) + 4 * n + (i & 3); }

struct Unit { int pm, pn; };
struct Gemm { const bf16_t* A; const bf16_t* Bt; int M, N, K; };

struct StaticOrder {
    int nM, nN, nwg, G, c;
    __host__ __device__ void init(int M, int N, int G_, int c_) { nM = M / BM; nN = N / BM; nwg = nM * nN; G = G_; c = c_; }
    __host__ __device__ bool next(int i, Unit& u) const {
        const long L = (long)i * G + c; if (L >= nwg) return false;
        int wgid = (int)L; { const int q = nwg / NXCD, r = nwg % NXCD, xcd = wgid % NXCD, off = wgid / NXCD; wgid = (xcd < r ? xcd * (q + 1) : r * (q + 1) + (xcd - r) * q) + off; }
        const int nig = WGM * nN, gid = wgid / nig, fm = gid * WGM, gsz = (nM - fm) < WGM ? (nM - fm) : WGM;
        u.pm = fm + ((wgid % nig) % gsz); u.pn = (wgid % nig) / gsz; return true;
    }
    __device__ __forceinline__ unsigned arow_raw(const Unit&, int) const { return 0u; }
    __device__ __forceinline__ unsigned arow_fin(unsigned) const { return 0u; }
#if defined(EPI_VAR)
    bool skip_epi = false; __device__ __forceinline__ bool probe_skip_epi() const { return skip_epi; }
#endif
};

__device__ __forceinline__ unsigned cvt_pk_bf16(float lo, float hi) { unsigned r; asm volatile("v_cvt_pk_bf16_f32 %0, %1, %2" : "=v"(r) : "v"(lo), "v"(hi)); return r; }
__device__ __forceinline__ u32x4 pack8(const f32x4 a, const f32x4 b) { u32x4 w; w.x = cvt_pk_bf16(a[0], a[1]); w.y = cvt_pk_bf16(a[2], a[3]); w.z = cvt_pk_bf16(b[0], b[1]); w.w = cvt_pk_bf16(b[2], b[3]); return w; }

template <class Epi, class Sched, bool ALIGN_EPI, bool GATHER, bool FP8 = false>
__device__ __forceinline__ void gemm_phase(PG8_LAS unsigned char* lds, const Gemm g, const Sched& S, const Epi& E) {
    const int tid = threadIdx.x, wid = __builtin_amdgcn_readfirstlane(tid >> 6), lane = tid & 63, wr = wid >> 2, wc = wid & 3, fr = lane & 15, fq = lane >> 4;
    const int KB = FP8 ? g.K : g.K * 2, nt = KB / (BK * 2);
    unsigned voffA[2], voffB[2];
#pragma unroll
    for (int i = 0; i < 2; ++i) { int R, C; stage_rc(tid * 16 + i * 8192, R, C); const int Rb = Epi::PERM ? ((R & ~31) + perm32(R & 31)) : R;
        voffA[i] = (unsigned)(R * KB + C * 2); voffB[i] = (unsigned)(Rb * KB + C * 2); }
    const size_t kstep = (size_t)(BK * 2);
    const size_t hstep = (size_t)HALF * KB;
    const size_t tstep = 2 * hstep;
    const unsigned ldsw = (unsigned)wid * 1024u;
    const int aoff = lds_byte(wr * 64 + fr, fq * 8), boff = lds_byte(wc * 32 + fr, fq * 8);
    unsigned cvo[2][2], nvo[2][2];
#define PG8_SA(b, h) (((b) * 2 + (h)) * HTB)
#define PG8_SB(b, h) ((4 + (b) * 2 + (h)) * HTB)
#define PG8_STAGE(bufoff, gbase, voff) do { _Pragma("unroll") for (int _i = 0; _i < 2; ++_i) \
        __builtin_amdgcn_global_load_lds((const unsigned*)((const char*)(gbase) + (voff)[_i]), (PG8_LAS unsigned*)(lds + (bufoff) + ldsw + _i * 8192), 16, 0, 0); } while (0)
#define PG8_STGA(bufoff, gbase, hh, USE_NEXT) do { if constexpr (GATHER) { _Pragma("unroll") for (int _i = 0; _i < 2; ++_i) { \
        __builtin_amdgcn_global_load_lds((const unsigned*)((const char*)(gbase) + cvo[hh][_i]), (PG8_LAS unsigned*)(lds + (bufoff) + ldsw + _i * 8192), 16, 0, 0); } } \
        else { PG8_STAGE(bufoff, (gbase) + (hh) * hstep, voffA); } } while (0)
#define PG8_LDA(dst, b, h) do { _Pragma("unroll") for (int m = 0; m < 4; ++m) _Pragma("unroll") for (int k = 0; k < 2; ++k) dst[m][k] = *(const PG8_LAS bf16x8*)(lds + PG8_SA(b, h) + aoff + m * 2048 + k * 1024); } while (0)
#define PG8_LDB(dst, b, h) do { _Pragma("unroll") for (int n = 0; n < 2; ++n) _Pragma("unroll") for (int k = 0; k < 2; ++k) dst[n][k] = *(const PG8_LAS bf16x8*)(lds + PG8_SB(b, h) + boff + n * 2048 + k * 1024); } while (0)
#define PG8_SC mxsc
#define PG8_CAT8(x) __builtin_shufflevector(__builtin_bit_cast(i32x4, (x)[0]), __builtin_bit_cast(i32x4, (x)[1]), 0, 1, 2, 3, 4, 5, 6, 7)
#define PG8_MMA(ai, bj, At, Bt) do { __builtin_amdgcn_s_setprio(1); if constexpr (FP8) { _Pragma("unroll") for (int m = 0; m < 4; ++m) _Pragma("unroll") for (int n = 0; n < 2; ++n) \
        acc[ai][bj][m][n] = __builtin_amdgcn_mfma_scale_f32_16x16x128_f8f6f4(PG8_CAT8(Bt[n]), PG8_CAT8(At[m]), acc[ai][bj][m][n], 0, 0, 0, PG8_SC, 0, PG8_SC); } \
      else { _Pragma("unroll") for (int m = 0; m < 4; ++m) _Pragma("unroll") for (int n = 0; n < 2; ++n) _Pragma("unroll") for (int k = 0; k < 2; ++k) \
        acc[ai][bj][m][n] = __builtin_amdgcn_mfma_f32_16x16x32_bf16(Bt[n][k], At[m][k], acc[ai][bj][m][n], 0, 0, 0); } __builtin_amdgcn_s_setprio(0); } while (0)
#define PG8_WAIT_V(n) asm volatile("s_waitcnt vmcnt(" #n ")" ::: "memory")
#define PG8_WAIT_L(n) asm volatile("s_waitcnt lgkmcnt(" #n ")" ::: "memory")
#define PG8_BAR __builtin_amdgcn_s_barrier()
#define PG8_SCHED __builtin_amdgcn_sched_barrier(0)
#define PG8_GRAW(dst, un) do { if constexpr (GATHER) { _Pragma("unroll") for (int _i = 0; _i < 2; ++_i) { int R_, C_; stage_rc(tid * 16 + _i * 8192, R_, C_); \
        _Pragma("unroll") for (int _h = 0; _h < 2; ++_h) dst[_h][_i] = S.arow_raw(un, _h * HALF + R_); } } } while (0)
#define PG8_GFIN(dst, src) do { if constexpr (GATHER) { _Pragma("unroll") for (int _i = 0; _i < 2; ++_i) { int R_, C_; stage_rc(tid * 16 + _i * 8192, R_, C_); \
        _Pragma("unroll") for (int _h = 0; _h < 2; ++_h) dst[_h][_i] = S.arow_fin(src[_h][_i]) + (unsigned)C_ * 2u; } } } while (0)
    int mxsc = 0; if constexpr (FP8) asm volatile("s_mov_b32 %0, 0x7f7f7f7f" : "=s"(mxsc));
    Unit cur, nxt; int ui = 0;
    if (!S.next(0, cur)) return;
    f32x4 acc[2][2][4][2];
#pragma unroll
    for (int a = 0; a < 2; ++a)
#pragma unroll
        for (int b = 0; b < 2; ++b)
#pragma unroll
            for (int m = 0; m < 4; ++m)
#pragma unroll
                for (int n = 0; n < 2; ++n) acc[a][b][m][n] = (f32x4){0.f, 0.f, 0.f, 0.f};
    bf16x8 At[4][2], B0[2][2], B1[2][2];
    const char* cA = GATHER ? (const char*)g.A : (const char*)g.A + (size_t)cur.pm * tstep; const char* cB = (const char*)g.Bt + (size_t)cur.pn * tstep;
    PG8_GRAW(nvo, cur); PG8_GFIN(cvo, nvo);
    typename Epi::Meta meta = E.prefetch(cur, wr, fr);
    PG8_STAGE(PG8_SB(0, 0), cB, voffB); PG8_STAGE(PG8_SB(0, 1), cB + hstep, voffB); PG8_STGA(PG8_SA(0, 0), cA, 0, false); PG8_STGA(PG8_SA(0, 1), cA, 1, false);
    if (wr == 1) PG8_BAR;
    PG8_WAIT_V(2); PG8_BAR;
    PG8_STAGE(PG8_SB(1, 0), cB + kstep, voffB); PG8_STGA(PG8_SA(1, 0), cA + kstep, 0, false); PG8_STAGE(PG8_SB(1, 1), cB + hstep + kstep, voffB);
    PG8_WAIT_V(6); PG8_BAR;
    for (;;) {
        const bool has_next = S.next(ui + 1, nxt);
        if constexpr (GATHER) { if (has_next) PG8_GRAW(nvo, nxt); }
        const char* nA = GATHER ? (const char*)g.A : (has_next ? (const char*)g.A + (size_t)nxt.pm * tstep : cA); const char* nB = has_next ? (const char*)g.Bt + (size_t)nxt.pn * tstep : cB;
#pragma nounroll
        for (int t = 0; t < nt; t += 2) {
            const bool last = (t == nt - 2);
            const char* a1 = cA + (size_t)(t + 1) * kstep;
            const char* a2 = last ? nA : cA + (size_t)(t + 2) * kstep; const char* b2 = last ? nB : cB + (size_t)(t + 2) * kstep;
            const char* a3 = a2 + kstep; const char* b3 = b2 + kstep;
            PG8_LDB(B0, 0, 0); PG8_LDB(B1, 0, 1); PG8_SCHED; PG8_LDA(At, 0, 0); PG8_STGA(PG8_SA(1, 1), a1, 1, false);
            if constexpr (GATHER) { if (last && has_next) { asm volatile("" : "+v"(nvo[0][0]), "+v"(nvo[0][1]), "+v"(nvo[1][0]), "+v"(nvo[1][1])); PG8_GFIN(cvo, nvo); } }
            PG8_WAIT_V(8); PG8_WAIT_L(0); PG8_BAR; PG8_MMA(0, 0, At, B0); PG8_MMA(0, 1, At, B1); PG8_BAR; PG8_SCHED;
            PG8_LDA(At, 0, 1); PG8_STAGE(PG8_SB(0, 0), b2, voffB); PG8_STAGE(PG8_SB(0, 1), b2 + hstep, voffB); PG8_STGA(PG8_SA(0, 0), a2, 0, last);
            PG8_WAIT_V(8); PG8_WAIT_L(0); PG8_BAR; PG8_MMA(1, 0, At, B0); PG8_MMA(1, 1, At, B1); PG8_BAR; PG8_SCHED;
            PG8_LDB(B0, 1, 0); PG8_LDB(B1, 1, 1); PG8_SCHED; PG8_LDA(At, 1, 0); PG8_STGA(PG8_SA(0, 1), a2, 1, last);
            PG8_WAIT_V(8); PG8_WAIT_L(0); PG8_BAR; PG8_MMA(0, 0, At, B0); PG8_MMA(0, 1, At, B1); PG8_BAR; PG8_SCHED;
            PG8_LDA(At, 1, 1); PG8_STAGE(PG8_SB(1, 0), b3, voffB); PG8_STAGE(PG8_SB(1, 1), b3 + hstep, voffB); PG8_STGA(PG8_SA(1, 0), a3, 0, last);
            PG8_WAIT_V(8); PG8_WAIT_L(0); PG8_BAR; PG8_MMA(1, 0, At, B0); PG8_MMA(1, 1, At, B1); PG8_BAR; PG8_SCHED;
        }
        if constexpr (ALIGN_EPI) { if (wr == 0) PG8_BAR; }
#if defined(EPI_VAR)
        if (S.probe_skip_epi()) { _Pragma("unroll") for (int a_ = 0; a_ < 2; ++a_) _Pragma("unroll") for (int b_ = 0; b_ < 2; ++b_) _Pragma("unroll") for (int m_ = 0; m_ < 4; ++m_) asm volatile("" :: "v"(acc[a_][b_][m_][0]), "v"(acc[a_][b_][m_][1])); } else
#endif
        E(acc, cur, wr, wc, fr, fq, meta);
        if (!has_next) break;
#pragma unroll
        for (int a = 0; a < 2; ++a)
#pragma unroll
            for (int b = 0; b < 2; ++b)
#pragma unroll
                for (int m = 0; m < 4; ++m)
#pragma unroll
                    for (int n = 0; n < 2; ++n) acc[a][b][m][n] = (f32x4){0.f, 0.f, 0.f, 0.f};
        cur = nxt; cA = nA; cB = nB; ++ui;
        meta = E.prefetch(cur, wr, fr);
        if constexpr (ALIGN_EPI) { if (wr == 1) PG8_BAR; }
    }
    PG8_WAIT_V(0);
    if constexpr (!ALIGN_EPI) { if (wr == 0) PG8_BAR; }
    PG8_BAR;
#undef PG8_SA
#undef PG8_SB
#undef PG8_STAGE
#undef PG8_STGA
#undef PG8_LDA
#undef PG8_LDB
#undef PG8_MMA
#undef PG8_CAT8
#undef PG8_SC
#undef PG8_WAIT_V
#undef PG8_WAIT_L
#undef PG8_BAR
#undef PG8_SCHED
#undef PG8_GRAW
#undef PG8_GFIN
}
}
__device__ __forceinline__ unsigned long long rt() { return __builtin_amdgcn_s_memrealtime(); }
__device__ __forceinline__ unsigned f2bf(float f) { unsigned u = __builtin_bit_cast(unsigned, f); return (u + 0x7fffu + ((u >> 16) & 1u)) >> 16; }
__device__ __forceinline__ unsigned pk2(float lo, float hi) { return f2bf(lo) | (f2bf(hi) << 16); }
#define XB_TMO      128
#define XB_XCNT(j)  (256  + 64 * (j))
#define XB_XSUB(j)  (1280 + 64 * (j))
#define XB_XGEN(j)  (2304 + 64 * (j))
#define XB_TOP      3328
#define XB_TOPGEN   3392
#define XCD_BAR_WORDS 3456
#define XB_SPIN_CAP (1u << 18)

__device__ __forceinline__ unsigned xb_ld(unsigned* p)              { return __hip_atomic_load(p, __ATOMIC_RELAXED, __HIP_MEMORY_SCOPE_AGENT); }
__device__ __forceinline__ unsigned xb_add(unsigned* p, unsigned v) { return __hip_atomic_fetch_add(p, v, __ATOMIC_RELAXED, __HIP_MEMORY_SCOPE_AGENT); }
__device__ __forceinline__ unsigned xb_xcc_id() { return (unsigned)__builtin_amdgcn_s_getreg((3 << 11) | 20) & 0xFu; }
#define XB_SPIN(cond, bar) do { unsigned _sp = 0; while (cond) { __builtin_amdgcn_s_sleep(1); \
    if ((++_sp & 255u) == 0u) { if (xb_ld(&(bar)[XB_TMO])) break; if (_sp > XB_SPIN_CAP) { atomicAdd(&(bar)[XB_TMO], 1u); break; } } } } while (0)

struct XcdBarrier {
    unsigned* bar; unsigned x;
    volatile LAS unsigned* st;
};

__device__ __forceinline__ XcdBarrier xcd_barrier_post(unsigned* bar, volatile LAS unsigned* st) {
    XcdBarrier b; b.bar = bar; b.x = xb_xcc_id(); b.st = st;
    if (threadIdx.x == 0) (void)xb_add(&bar[XB_XCNT(b.x)], 1u);
    return b;
}
__device__ __forceinline__ void xcd_barrier_complete(unsigned* bar, unsigned x, unsigned& nloc, unsigned& nx) {
    const unsigned G = gridDim.x * gridDim.y * gridDim.z;
    unsigned sum, cnt, mine, sp = 0u;
    for (;;) {
        sum = 0u; cnt = 0u; mine = 0u;
#pragma unroll
        for (unsigned j = 0; j < 16; ++j) { const unsigned c = xb_ld(&bar[XB_XCNT(j)]); sum += c; cnt += (c > 0u) ? 1u : 0u; mine = (j == x) ? c : mine; }
        if (sum == G) break;
        __builtin_amdgcn_s_sleep(1);
        if ((++sp & 255u) == 0u) { if (xb_ld(&bar[XB_TMO])) break; if (sp > XB_SPIN_CAP) { atomicAdd(&bar[XB_TMO], 1u); break; } }
    }
    nloc = mine > 0u ? mine : 1u; nx = cnt > 0u ? cnt : 1u;
}

__device__ __forceinline__ void xcd_barrier(const XcdBarrier& b) {
    asm volatile("s_waitcnt vmcnt(0)" ::: "memory");
    __syncthreads();
    if (threadIdx.x == 0) {
        unsigned* bar = b.bar;
        __builtin_amdgcn_s_waitcnt(0);
        unsigned nloc = b.st[0], nx = b.st[1];
        if (nloc == 0u) { xcd_barrier_complete(bar, b.x, nloc, nx); b.st[0] = nloc; b.st[1] = nx; }
        const unsigned old = xb_add(&bar[XB_XSUB(b.x)], 1u);
        const unsigned gen = old / nloc;
        if (old + 1u == (gen + 1u) * nloc) {
            __builtin_amdgcn_fence(__ATOMIC_RELEASE, "agent");
            asm volatile("s_waitcnt vmcnt(0)" ::: "memory");
            const unsigned og = xb_add(&bar[XB_TOP], 1u);
            const unsigned tg = og / nx;
            if (og + 1u == (tg + 1u) * nx) xb_add(&bar[XB_TOPGEN], 1u);
            else XB_SPIN(xb_ld(&bar[XB_TOPGEN]) == tg, bar);
            __builtin_amdgcn_fence(__ATOMIC_ACQUIRE, "agent");
            xb_add(&bar[XB_XGEN(b.x)], 1u);
            asm volatile("s_waitcnt vmcnt(0)" ::: "memory");
        } else {
            XB_SPIN(xb_ld(&bar[XB_XGEN(b.x)]) == gen, bar);
            __builtin_amdgcn_fence(__ATOMIC_ACQUIRE, "agent");
            asm volatile("s_waitcnt vmcnt(0)" ::: "memory");
        }
    }
    __syncthreads();
}

using pg8::Unit; using pg8::pack8;
typedef pg8::u32x4 u32x4;

struct NoMeta {};
struct EpiInProj {
    static constexpr bool PERM = true; typedef NoMeta Meta;
    __device__ __forceinline__ Meta prefetch(const Unit&, int, int) const { return Meta{}; }
    bf16* cb; bf16* ccx; bf16* Qb; bf16* Kb; bf16* Vb; const float* ropec; const float* ropes; const float* gq; const float* gk;
    __device__ __forceinline__ void operator()(const f32x4 (&acc)[2][2][4][2], const Unit& u, int wr, int wc, int fr, int fq, const NoMeta&) const {
        asm volatile("" : "+v"(fr), "+v"(fq));
        const int pn = __builtin_amdgcn_readfirstlane(u.pn), pm = __builtin_amdgcn_readfirstlane(u.pm); const bool meta = (pm == NTOK / 256);
#define EPI_FENCE() asm volatile("" ::: "memory")
        if (pn < 2) {
            if (!meta) {
#pragma unroll
                for (int ai = 0; ai < 2; ++ai)
#pragma unroll
                    for (int m = 0; m < 4; ++m) { const int R = pm * 256 + ai * 128 + wr * 64 + m * 16 + fr;
#pragma unroll
                        for (int bj = 0; bj < 2; ++bj) *(u32x4*)(cb + (size_t)R * CONVW + 256 * pn + 128 * bj + 32 * wc + 8 * fq) = pack8(acc[ai][bj][m][0], acc[ai][bj][m][1]);
                        if (m & 1) EPI_FENCE(); } }
        } else if (pn < 6) {
#pragma unroll
            for (int ai = 0; ai < 2; ++ai)
#pragma unroll
                for (int m = 0; m < 4; ++m) { const int rl = ai * 128 + wr * 64 + m * 16 + fr, R = pm * 256 + rl; const int b = R >> 13, i = R & (SEQ - 1);
                    const u32x4 w = pack8(acc[ai][0][m][0] * acc[ai][1][m][0], acc[ai][0][m][1] * acc[ai][1][m][1]);
                    const int col = 128 * (pn - 2) + 32 * wc + 8 * fq;
                    if (!meta) *(u32x4*)(ccx + ((size_t)(b * CCXROWS + 2 + i)) * CONVW + col) = w;
                    else if (rl == 14 || rl == 15) {
#pragma unroll
                        for (int bb = 0; bb < BATCH; ++bb) *(u32x4*)(ccx + ((size_t)(bb * CCXROWS + rl - 14)) * CONVW + col) = w; }
                    if (m & 1) EPI_FENCE(); }
        } else if (pn < 10) {
            const bool isq = pn < 8; const float* g = isq ? gq : gk;
            const int hm = 4 * ((pn - 6) & 1) + wc, head = hm >> 1, mp = hm & 1;
            f32x4 gv[2][2];
#pragma unroll
            for (int bj = 0; bj < 2; ++bj)
#pragma unroll
                for (int n = 0; n < 2; ++n) gv[bj][n] = *(const f32x4*)(g + qk_delta(4 * bj + fq, 4 * n));
#pragma unroll
            for (int ai = 0; ai < 2; ++ai) {
                f32x4 rc[4], rn[4];
#pragma unroll
                for (int m = 0; m < 4; ++m) { const int rl = ai * 128 + wr * 64 + m * 16 + fr, R = pm * 256 + rl, i = R & (SEQ - 1), pos = meta ? (rl & 15) : NMETA + i;
                    rc[m] = *(const f32x4*)(ropec + pos * 8 + 4 * (fq & 1)); rn[m] = *(const f32x4*)(ropes + pos * 8 + 4 * (fq & 1)); }
                EPI_FENCE();
#pragma unroll
                for (int m = 0; m < 4; ++m) {
                    const int rl = ai * 128 + wr * 64 + m * 16 + fr, R = pm * 256 + rl; const int b = R >> 13, i = R & (SEQ - 1);
                    f32x4 y[2][2]; float ss = 0.f;
#pragma unroll
                    for (int bj = 0; bj < 2; ++bj)
#pragma unroll
                        for (int n = 0; n < 2; ++n) { y[bj][n] = acc[ai][bj][m][n]; const f32x4 q = y[bj][n] * y[bj][n]; ss += (q[0] + q[1]) + (q[2] + q[3]); }
                    ss += __shfl_xor(ss, 16); ss += __shfl_xor(ss, 32);
                    const float r = rsqrtf(ss * (1.0f / 64.0f) + EPS) * (isq ? QSCALE : 1.0f);
#pragma unroll
                    for (int bj = 0; bj < 2; ++bj)
#pragma unroll
                        for (int n = 0; n < 2; ++n) y[bj][n] = y[bj][n] * r * gv[bj][n];
                    {
                        const f32x4 a = y[0][0], bq = y[0][1], ra = a * rc[m] - bq * rn[m], rb = bq * rc[m] + a * rn[m];
                        y[0][0] = fq < 2 ? ra : a; y[0][1] = fq < 2 ? rb : bq;
                    }
#pragma unroll
                    for (int bj = 0; bj < 2; ++bj) { const u32x4 w = pack8(y[bj][0], y[bj][1]);
                        if (isq) { if (!meta) *(u32x4*)(Qb + q_off(b, head, mp, i, 4 * bj + fq)) = w; }
                        else if (!meta) *(u32x4*)(Kb + k_off(b, head, (i >> 6) + 1, mp, 4 * bj + fq, i & 63)) = w;
                        else if (rl < NMETA) {
#pragma unroll
                            for (int bb = 0; bb < BATCH; ++bb) *(u32x4*)(Kb + k_off(bb, head, 0, mp, 4 * bj + fq, 48 + rl)) = w; } }
                }
                EPI_FENCE();
            }
        } else {
#pragma unroll
            for (int ai = 0; ai < 2; ++ai)
#pragma unroll
                for (int m = 0; m < 4; ++m) { const int rl = ai * 128 + wr * 64 + m * 16 + fr, R = pm * 256 + rl; const int b = R >> 13, i = R & (SEQ - 1);
#pragma unroll
                    for (int bj = 0; bj < 2; ++bj) { const int head = 2 * (pn - 10) + bj; const u32x4 w = pack8(acc[ai][bj][m][0], acc[ai][bj][m][1]);
                        if (!meta) *(u32x4*)(Vb + v_off(b, head, (i >> 6) + 1, wc, i & 63, 8 * fq)) = w;
                        else if (rl < NMETA) {
#pragma unroll
                            for (int bb = 0; bb < BATCH; ++bb) *(u32x4*)(Vb + v_off(bb, head, 0, wc, 48 + rl, 8 * fq)) = w; } }
                    if (m & 1) EPI_FENCE(); }
        }
#undef EPI_FENCE
    }
};

__device__ __forceinline__ f32x4 bf2f4_lo(unsigned a, unsigned b) { return (f32x4){__builtin_bit_cast(float, a << 16), __builtin_bit_cast(float, a & 0xffff0000u), __builtin_bit_cast(float, b << 16), __builtin_bit_cast(float, b & 0xffff0000u)}; }
typedef int i2v __attribute__((ext_vector_type(2)));
__device__ __forceinline__ i2v pack8_f8(const f32x4 a, const f32x4 b) {
    int w0 = 0, w1 = 0; w0 = __builtin_amdgcn_cvt_pk_fp8_f32(a[0], a[1], w0, false); w0 = __builtin_amdgcn_cvt_pk_fp8_f32(a[2], a[3], w0, true);
    w1 = __builtin_amdgcn_cvt_pk_fp8_f32(b[0], b[1], w1, false); w1 = __builtin_amdgcn_cvt_pk_fp8_f32(b[2], b[3], w1, true); return (i2v){w0, w1}; }
struct EpiOutProj {
    static constexpr bool PERM = true; typedef NoMeta Meta;
    __device__ __forceinline__ Meta prefetch(const Unit&, int, int) const { return Meta{}; }
    bf16* hb; unsigned char* hq; const float* xrms;
    __device__ __forceinline__ void operator()(const f32x4 (&acc)[2][2][4][2], const Unit& u, int wr, int wc, int fr, int fq, const NoMeta&) const {
        asm volatile("" : "+v"(fr), "+v"(fq));
        u32x4 xv[2][4][2]; float sx[2][4];
        bf16* const base = hb + ((size_t)u.pm * 256 + wr * 64 + fr) * DM + 256 * u.pn + 32 * wc + 8 * fq;
#pragma unroll
        for (int ai = 0; ai < 2; ++ai)
#pragma unroll
            for (int m = 0; m < 4; ++m) { sx[ai][m] = xrms[(size_t)u.pm * 256 + ai * 128 + wr * 64 + m * 16 + fr];
#pragma unroll
                for (int bj = 0; bj < 2; ++bj) xv[ai][m][bj] = *(const u32x4*)(base + (size_t)(ai * 128 + m * 16) * DM + 128 * bj); }
        __builtin_amdgcn_sched_barrier(0); asm volatile("" ::: "memory");
#pragma unroll
        for (int ai = 0; ai < 2; ++ai)
#pragma unroll
            for (int m = 0; m < 4; ++m) {
                const size_t R = (size_t)u.pm * 256 + ai * 128 + wr * 64 + m * 16 + fr;
#pragma unroll
                for (int bj = 0; bj < 2; ++bj) { const u32x4 x4 = xv[ai][m][bj];
                    const f32x4 h0 = bf2f4_lo(x4.x, x4.y) * sx[ai][m] + acc[ai][bj][m][0], h1 = bf2f4_lo(x4.z, x4.w) * sx[ai][m] + acc[ai][bj][m][1];
                    *(u32x4*)(base + (size_t)(ai * 128 + m * 16) * DM + 128 * bj) = pack8(h0, h1);
                    *(i2v*)(hq + R * DM + 256 * u.pn + 128 * bj + 32 * wc + 8 * fq) = pack8_f8(h0 * F8S_H, h1 * F8S_H); }
            }
    }
};

struct MoeTab { const LAS int* blkstart; const LAS int* cnt; };

struct EpiMoe1 {
    static constexpr bool PERM = true;
    MoeTab tb; const float* rowrs; unsigned char* hid;
    struct Meta { float rs[8]; };
    __device__ __forceinline__ Meta prefetch(const Unit& u, int wr, int fr) const {
        asm volatile("" : "+v"(fr));
        const int e = u.pn >> 2, rb = u.pm - tb.blkstart[e], cn = tb.cnt[e]; Meta mt;
#pragma unroll
        for (int q = 0; q < 8; ++q) { const int idx = rb * 256 + (q >> 2) * 128 + wr * 64 + (q & 3) * 16 + fr; const float v = rowrs[(size_t)e * CAP + (idx < cn ? idx : cn - 1)];
            mt.rs[q] = idx < cn ? v * (1.0f / (F8S_H * F8S_W)) : 0.f; }
        return mt;
    }
    __device__ __forceinline__ void operator()(const f32x4 (&acc)[2][2][4][2], const Unit& u, int wr, int wc, int fr, int fq, const Meta& mt) const {
        asm volatile("" : "+v"(fr), "+v"(fq));
        const int ct = u.pn & 3;
#pragma unroll
        for (int ai = 0; ai < 2; ++ai)
#pragma unroll
            for (int m = 0; m < 4; ++m) {
                const int rl = ai * 128 + wr * 64 + m * 16 + fr; const float rs = mt.rs[ai * 4 + m];
                if (rs != 0.f) {
                    f32x4 hv[2];
#pragma unroll
                    for (int n = 0; n < 2; ++n) { const f32x4 g = acc[ai][0][m][n] * rs, up = acc[ai][1][m][n] * rs;
#pragma unroll
                        for (int j = 0; j < 4; ++j) hv[n][j] = g[j] * __builtin_amdgcn_rcpf(1.0f + __builtin_amdgcn_exp2f(-1.4426950408889634f * g[j])) * (up[j] * F8S_HID); }
                    *(i2v*)(hid + ((size_t)u.pm * 256 + rl) * DFF + 128 * ct + 32 * wc + 8 * fq) = pack8_f8(hv[0], hv[1]);
                }
            }
    }
};

constexpr float Y8_SCALE = 16.0f;
struct EpiMoe2 {
    static constexpr bool PERM = true;
    MoeTab tb; const int* rowpair; bf16* ybuf;
    struct Meta { unsigned w[8]; };
    __device__ __forceinline__ Meta prefetch(const Unit& u, int wr, int fr) const {
        asm volatile("" : "+v"(fr));
        const int e = u.pn >> 2, rb = u.pm - tb.blkstart[e], cn = tb.cnt[e]; Meta mt;
#pragma unroll
        for (int q = 0; q < 8; ++q) { const int idx = rb * 256 + (q >> 2) * 128 + wr * 64 + (q & 3) * 16 + fr;
            const unsigned w = (unsigned)rowpair[(size_t)e * CAP + (idx < cn ? idx : cn - 1)]; mt.w[q] = idx < cn ? w : 0u; }
        return mt;
    }
    __device__ __forceinline__ void operator()(const f32x4 (&acc)[2][2][4][2], const Unit& u, int wr, int wc, int fr, int fq, const Meta& mt) const {
        asm volatile("" : "+v"(fr), "+v"(fq));
        const int ct = u.pn & 3;
#pragma unroll
        for (int ai = 0; ai < 2; ++ai)
#pragma unroll
            for (int m = 0; m < 4; ++m) {
                const unsigned w = mt.w[ai * 4 + m]; const int pr = (int)(w & 0xffffu); const float gt = __builtin_bit_cast(float, w & 0xffff0000u);
                if (w != 0u) {
                    const float gs = gt * (Y8_SCALE / (F8S_HID * F8S_W));
#pragma unroll
                    for (int bj = 0; bj < 2; ++bj)
                        *(i2v*)((unsigned char*)ybuf + (size_t)pr * DM + 256 * ct + 128 * bj + 32 * wc + 8 * fq) = pack8_f8(acc[ai][bj][m][0] * gs, acc[ai][bj][m][1] * gs);
                }
            }
    }
};

template <bool IDENT> struct MoeOrderT {
    int G, c, nunits, K; MoeTab tb; const int* rowpair;
#if defined(EPI_VAR)
    bool skip_epi = false; __device__ __forceinline__ bool probe_skip_epi() const { return skip_epi; }
#endif
    __device__ __forceinline__ bool next(int i, Unit& u) const {
        pg8::StaticOrder so; so.nM = nunits >> 2; so.nN = 4; so.nwg = nunits; so.G = G; so.c = c;
        Unit t; if (!so.next(i, t)) return false;
        int e = 0;
        for (int j = 1; j < NEXP; ++j) e += (tb.blkstart[j] <= t.pm) ? 1 : 0;
        u.pm = __builtin_amdgcn_readfirstlane(t.pm); u.pn = __builtin_amdgcn_readfirstlane(4 * e + t.pn); return true;
    }
    __device__ __forceinline__ unsigned arow_raw(const Unit& u, int r) const {
        if constexpr (IDENT) return (unsigned)(u.pm * 256 + r);
        const int e = u.pn >> 2, idx = (u.pm - tb.blkstart[e]) * 256 + r, cn = tb.cnt[e];
        return (unsigned)rowpair[(size_t)e * CAP + (idx < cn ? idx : cn - 1)];
    }
    __device__ __forceinline__ unsigned arow_fin(unsigned raw) const { return (IDENT ? raw : ((raw & 0xffffu) >> 1)) * (unsigned)K; }
};

constexpr int NWAVES = 8;
constexpr int RING_OFF = 0, RING_BYTES = 131072;
constexpr int LDSCTL_OFF = RING_BYTES, MISC_OFF = LDSCTL_OFF + 320;
constexpr int TAB_OFF = LDSCTL_OFF + 1024;
constexpr int LDS_BYTES = 147456;
struct Frame {
    LAS unsigned char* lds; volatile LAS unsigned* MISC; gu32* ctl;
    int tid, lane, wave, vcu, G;
};
struct Args { const float* in[21]; float* out; unsigned char* ws; int ph_lo, ph_hi; };

__device__ __forceinline__ float wave_sum(float v) {
#pragma unroll
    for (int o = 1; o < 64; o <<= 1) v += __shfl_xor(v, o);
    return v;
}
__device__ __forceinline__ float wave_max(float v) {
#pragma unroll
    for (int o = 1; o < 64; o <<= 1) v = fmaxf(v, __shfl_xor(v, o));
    return v;
}

template <bool NTST, class ColPtr>
__device__ __forceinline__ void p0_transpose_item(const ColPtr& src, int ldw, int K, int N, const float* gain, bf16* WT, LAS unsigned* scr, int item, int lane) {
    const int nblk = N / 64, kb = item / nblk, nb = item % nblk, k0 = 64 * kb, n0 = 64 * nb;
    const float* colp = src(n0 + lane) + (size_t)k0 * ldw;
    float v[64];
#pragma unroll
    for (int i = 0; i < 64; ++i) v[i] = __builtin_nontemporal_load(colp + (size_t)i * ldw);
    if (gain) {
#pragma unroll
        for (int i = 0; i < 64; ++i) v[i] *= gain[k0 + i]; }
#pragma unroll
    for (int i = 0; i < 32; ++i) scr[lane * 34 + i] = pk2(v[2 * i], v[2 * i + 1]);
    LDS_WAIT(); asm volatile("" ::: "memory");
    const int c = lane & 7;
#pragma unroll
    for (int j = 0; j < 8; ++j) { const int n = (lane >> 3) + 8 * j; const LAS unsigned long long* s = (const LAS unsigned long long*)(scr + n * 34 + 4 * c);
        const unsigned long long lo = s[0], hi = s[1];
        v4u o; o.x = (unsigned)lo; o.y = (unsigned)(lo >> 32); o.z = (unsigned)hi; o.w = (unsigned)(hi >> 32);
        if (NTST) __builtin_nontemporal_store(o, (GAS v4u*)(WT + (size_t)(n0 + n) * K + k0 + 8 * c)); else *(GAS v4u*)(WT + (size_t)(n0 + n) * K + k0 + 8 * c) = o; }
    LDS_WAIT(); asm volatile("" ::: "memory");
}
template <class ColPtr>
__device__ __forceinline__ void p0_transpose_item_f8(const ColPtr& src, int ldw, int K, int N, const float* gain, float scale, unsigned char* WT, LAS unsigned* scr, int item, int lane) {
    const int nblk = N / 64, kb = item / nblk, nb = item % nblk, k0 = 64 * kb, n0 = 64 * nb;
    const float* colp = src(n0 + lane) + (size_t)k0 * ldw;
    float v[64];
#pragma unroll
    for (int i = 0; i < 64; ++i) v[i] = __builtin_nontemporal_load(colp + (size_t)i * ldw);
    if (gain) {
#pragma unroll
        for (int i = 0; i < 64; ++i) v[i] *= gain[k0 + i] * scale; }
    else {
#pragma unroll
        for (int i = 0; i < 64; ++i) v[i] *= scale; }
#pragma unroll
    for (int i = 0; i < 16; ++i) { int w = 0; w = __builtin_amdgcn_cvt_pk_fp8_f32(v[4 * i], v[4 * i + 1], w, false); w = __builtin_amdgcn_cvt_pk_fp8_f32(v[4 * i + 2], v[4 * i + 3], w, true); scr[lane * 18 + i] = (unsigned)w; }
    LDS_WAIT(); asm volatile("" ::: "memory");
    const int c = lane & 3;
#pragma unroll
    for (int j = 0; j < 4; ++j) { const int n = (lane >> 2) + 16 * j; const LAS unsigned long long* s = (const LAS unsigned long long*)(scr + n * 18 + 4 * c);
        const unsigned long long lo = s[0], hi = s[1];
        v4u o; o.x = (unsigned)lo; o.y = (unsigned)(lo >> 32); o.z = (unsigned)hi; o.w = (unsigned)(hi >> 32);
        __builtin_nontemporal_store(o, (GAS v4u*)(WT + (size_t)(n0 + n) * K + k0 + 16 * c)); }
    LDS_WAIT(); asm volatile("" ::: "memory");
}
struct ColIn { const float* w; __device__ __forceinline__ const float* operator()(int n) const { return w + inproj_col(n); } };
struct ColPlain { const float* w; __device__ __forceinline__ const float* operator()(int n) const { return w + n; } };
struct ColGU { const float* wg; long long du; __device__ __forceinline__ const float* operator()(int n) const { const int ct = n >> 8, bj = (n >> 7) & 1, x = n & 127; return wg + (bj ? du : 0ll) + 128 * ct + x; } };

__device__ __forceinline__ double rope_invfreq(int i) {
    const double t[8] = {1.0, 0.19392274474868576, 0.03760603093086393, 0.007292664737217109, 0.001414213562373095, 0.0002742481756762073, 5.318295896944988e-05, 1.031338537721246e-05};
    double r = t[0];
#pragma unroll
    for (int j = 1; j < 8; ++j) r = (i == j) ? t[j] : r;
    return r;
}

__device__ __forceinline__ void p0_prologue(Frame& F, const Args& a, unsigned char* ws) {
    LAS unsigned* scr = (LAS unsigned*)(F.lds + RING_OFF + F.wave * 16384);
    const int gw = F.vcu * NWAVES + F.wave, NGW = F.G * NWAVES, lane = F.lane;
    const float* x = a.in[0]; const float* meta = a.in[1]; const float* g1 = a.in[2]; const float* w_in = a.in[3];
    const float* w_out = a.in[12]; const float* g2 = a.in[13]; const float* w_rg = a.in[14]; const float* w_re = a.in[16];
    bf16* Wt_in = (bf16*)(ws + WS_WIN); bf16* Wt_out = (bf16*)(ws + WS_WOUT);
    constexpr int I_IN = (DM / 64) * (INCOLS / 64), I_OUT = (DM / 64) * (DM / 64);
    for (int it = gw; it < I_IN + I_OUT; it += NGW) {
        if (it < I_IN) p0_transpose_item<false>(ColIn{w_in}, INCOLS, DM, INCOLS, g1, Wt_in, scr, it, lane);
        else p0_transpose_item<false>(ColPlain{w_out}, DM, DM, DM, nullptr, Wt_out, scr, it - I_IN, lane);
    }
    bf16* xb = (bf16*)(ws + WS_XB); float* xrms = (float*)(ws + WS_RSTD1);
    for (int R0 = 4 * gw; R0 < MROWS; R0 += 4 * NGW) {
        if (R0 >= NTOK + NMETA) {
#pragma unroll
            for (int q = 0; q < 4; ++q) { GAS unsigned long long* o8 = (GAS unsigned long long*)(xb + (size_t)(R0 + q) * DM) + lane;
#pragma unroll
                for (int j = 0; j < 4; ++j) o8[64 * j] = 0ull;
                if (lane == 0) xrms[R0 + q] = 1.0f; }
            continue; }
        f32x4 v[4][4];
#pragma unroll
        for (int q = 0; q < 4; ++q) { const int R = R0 + q;
            const float* xrow = R < NTOK ? x + (size_t)R * DM : meta + (size_t)((R - NTOK) & 15) * DM;
            const GAS f32x4* xr = (const GAS f32x4*)xrow + lane;
#pragma unroll
            for (int j = 0; j < 4; ++j) v[q][j] = __builtin_nontemporal_load(xr + 64 * j); }
#pragma unroll
        for (int q = 0; q < 4; ++q) { const int R = R0 + q; const bool pad = R >= NTOK + NMETA;
            float s = 0.f;
#pragma unroll
            for (int j = 0; j < 4; ++j) s += (v[q][j].x * v[q][j].x + v[q][j].y * v[q][j].y) + (v[q][j].z * v[q][j].z + v[q][j].w * v[q][j].w);
            s = wave_sum(s);
            const float ms = s * (1.0f / DM) + EPS, rs = rsqrtf(ms);
            if (lane == 0) xrms[R] = pad ? 1.0f : sqrtf(ms);
            GAS unsigned long long* o8 = (GAS unsigned long long*)(xb + (size_t)R * DM) + lane;
#pragma unroll
            for (int j = 0; j < 4; ++j) o8[64 * j] = pad ? 0ull : ((unsigned long long)pk2(v[q][j].x * rs, v[q][j].y * rs) | ((unsigned long long)pk2(v[q][j].z * rs, v[q][j].w * rs) << 32)); }
    }
    const int gt = F.vcu * (NWAVES * 64) + F.tid, NGT = F.G * NWAVES * 64;
    float* ropec = (float*)(ws + WS_ROPEC); float* ropes = (float*)(ws + WS_ROPES);
    for (int it = gt; it < (SEQ + NMETA) * 8; it += NGT) { const int pos = it >> 3, i = it & 7;
        const double rev = (double)pos * rope_invfreq(i) * 0.15915494309189535; const float fr = (float)(rev - __builtin_rint(rev));
        ropec[it] = __builtin_amdgcn_cosf(fr); ropes[it] = __builtin_amdgcn_sinf(fr); }
    float* wr = (float*)(ws + WS_WR);
    for (int it = gt; it < 64 * 3 * 64 * 4; it += NGT) { const int c = it & 3, ln = (it >> 2) & 63, cbk = it >> 8, cb = cbk % 3, kb = cbk / 3, k = 16 * kb + 4 * (ln >> 4) + c, j = 16 * cb + (ln & 15);
        wr[it] = j < 4 ? g2[k] * w_rg[k * NGRP + j] : (j < 36 ? g2[k] * w_re[k * NEXP + (j - 4)] : 0.f); }
    bf16* Kb = (bf16*)(ws + WS_K); bf16* Vb = (bf16*)(ws + WS_V);
    for (int it = gt; it < BATCH * NHEAD * 16 * 48; it += NGT) { const int bh = it / (16 * 48), r2 = it % (16 * 48), mc = r2 / 48, row = r2 % 48;
        *(GAS v4u*)(Kb + k_off(bh >> 2, bh & 3, 0, mc >> 3, mc & 7, row)) = (v4u){0u, 0u, 0u, 0u}; }
    for (int it = gt; it < BATCH * NHEAD * 4 * 48 * 4; it += NGT) { const int bh = it / (4 * 48 * 4), r2 = it % (4 * 48 * 4), dq = r2 / (48 * 4), r3 = r2 % (48 * 4), row = r3 >> 2, c8 = (r3 & 3) * 8;
        *(GAS v4u*)(Vb + v_off(bh >> 2, bh & 3, 0, dq, row, c8)) = (v4u){0u, 0u, 0u, 0u}; }
}

constexpr int EWC_ITEMS = NEXP * ((DM / 64) * (1024 / 64) + (DFF / 64) * (DM / 64)), EWC_SPLIT = (EWC_ITEMS * 45) / 100, EWC_GU = NEXP * (DM / 64) * (1024 / 64);
__device__ __forceinline__ void expert_weight_copies(Frame& F, const Args& a, unsigned char* ws, int sl, int nsl, int it_lo, int it_hi) {
    LAS unsigned* scr = (LAS unsigned*)(F.lds + RING_OFF + F.wave * 16384);
    const float* g2 = a.in[13]; const float* w_gate = a.in[18]; const float* w_up = a.in[19]; const float* w_down = a.in[20];
    unsigned char* Wgu = ws + WS_WGU; unsigned char* Wd = ws + WS_WD;
    constexpr int I_GU = (DM / 64) * (1024 / 64), I_D = (DFF / 64) * (DM / 64);
    for (int it = it_lo + sl; it < it_hi; it += nsl) {
        int r = it;
        if (r < NEXP * I_GU) { const int e = r / I_GU; p0_transpose_item_f8(ColGU{w_gate + (size_t)e * DM * DFF, (long long)(w_up - w_gate)}, DFF, DM, 1024, g2, F8S_W, Wgu + (size_t)e * 1024 * DM, scr, r % I_GU, F.lane); continue; }
        r -= NEXP * I_GU;
        { const int e = r / I_D; p0_transpose_item_f8(ColPlain{w_down + (size_t)e * DFF * DM}, DM, DFF, DM, nullptr, F8S_W, Wd + (size_t)e * DM * DFF, scr, r % I_D, F.lane); }
    }
}

__device__ __forceinline__ float bf2f(unsigned short v) { return __builtin_bit_cast(float, (unsigned)v << 16); }
__device__ __forceinline__ void conv_pass(Frame& F, const Args& a, unsigned char* ws) {
    const bf16* cb = (const bf16*)(ws + WS_CB); const bf16* ccx = (const bf16*)(ws + WS_CCX); bf16* mix = (bf16*)(ws + WS_MIX); const float* cw = a.in[4];
    const int gt = F.vcu * (NWAVES * 64) + F.tid, NGT = F.G * NWAVES * 64;
    constexpr int NIT = (NTOK / 2) * (CONVW / 8), UNR = 4;
    for (int it0 = gt; it0 < NIT; it0 += UNR * NGT) {
        v4u z[UNR][4], cbv[UNR][2];
#pragma unroll
        for (int u = 0; u < UNR; ++u) { const int it = it0 + u * NGT; if (it < NIT) {
            const int R = (it >> 6) * 2, c0 = (it & 63) * 8, b = R >> 13, i = R & (SEQ - 1);
            const bf16* zp = ccx + ((size_t)(b * CCXROWS + i)) * CONVW + c0;
#pragma unroll
            for (int r = 0; r < 4; ++r) z[u][r] = *(const GAS v4u*)(zp + r * CONVW);
            cbv[u][0] = *(const GAS v4u*)(cb + (size_t)R * CONVW + c0); cbv[u][1] = *(const GAS v4u*)(cb + (size_t)(R + 1) * CONVW + c0); } }
#pragma unroll
        for (int u = 0; u < UNR; ++u) { const int it = it0 + u * NGT; if (it < NIT) {
            const int R = (it >> 6) * 2, c0 = (it & 63) * 8;
            const f32x4 w0a = *(const f32x4*)(cw + c0), w0b = *(const f32x4*)(cw + c0 + 4), w1a = *(const f32x4*)(cw + CONVW + c0), w1b = *(const f32x4*)(cw + CONVW + c0 + 4),
                        w2a = *(const f32x4*)(cw + 2 * CONVW + c0), w2b = *(const f32x4*)(cw + 2 * CONVW + c0 + 4);
#pragma unroll
            for (int rr = 0; rr < 2; ++rr) { float o[8];
#pragma unroll
                for (int j = 0; j < 8; ++j) { const int sh = (j & 1) * 16; const int q = j >> 1;
                    const float a0 = __builtin_bit_cast(float, ((z[u][rr][q] >> sh) & 0xffffu) << 16), a1 = __builtin_bit_cast(float, ((z[u][rr + 1][q] >> sh) & 0xffffu) << 16), a2 = __builtin_bit_cast(float, ((z[u][rr + 2][q] >> sh) & 0xffffu) << 16);
                    const float cbf = __builtin_bit_cast(float, ((cbv[u][rr][q] >> sh) & 0xffffu) << 16);
                    const float x0 = j < 4 ? w0a[j & 3] : w0b[j & 3], x1 = j < 4 ? w1a[j & 3] : w1b[j & 3], x2 = j < 4 ? w2a[j & 3] : w2b[j & 3];
                    o[j] = cbf * (x0 * a0 + x1 * a1 + x2 * a2); }
                v4u w; w.x = pk2(o[0], o[1]); w.y = pk2(o[2], o[3]); w.z = pk2(o[4], o[5]); w.w = pk2(o[6], o[7]);
                *(GAS v4u*)(mix + (size_t)(R + rr) * DM + c0) = w; } } }
    }
}

namespace att {
#ifndef ATT_SG
#define ATT_SG 3
#endif
__device__ __forceinline__ int crow(int r, int hi) { return (r & 3) + 8 * (r >> 2) + 4 * hi; }
typedef short v4i16_t __attribute__((ext_vector_type(4)));
__device__ __forceinline__ s16x4 vtr(const LAS unsigned char* p) { return __builtin_bit_cast(s16x4, __builtin_amdgcn_ds_read_tr16_b64_v4i16((LAS v4i16_t*)p)); }
__device__ __forceinline__ unsigned cvtpk(float lo, float hi) { typedef float f2 __attribute__((ext_vector_type(2))); typedef __bf16 b2 __attribute__((ext_vector_type(2))); f2 v = {lo, hi}; b2 b = __builtin_convertvector(v, b2); return __builtin_bit_cast(unsigned, b); }

struct Par { const bf16* Qb; const bf16* Kb; const bf16* Vb; bf16* mix; const float* subg; float negM, lam; };

__device__ __forceinline__ void dma16(const GAS unsigned char* gbase, unsigned voff, LAS unsigned char* lds_dst) {
    asm volatile("s_mov_b32 m0, %2\n\ts_nop 0\n\tglobal_load_lds_dwordx4 %0, %1" :: "v"(voff), "s"(gbase), "s"((unsigned)(size_t)lds_dst) : "memory");
}
#define ATT_WAITBAR() do { asm volatile("s_waitcnt vmcnt(0) lgkmcnt(0)" ::: "memory"); __builtin_amdgcn_s_barrier(); asm volatile("" ::: "memory"); } while (0)
#define ATT_WAITBAR4() do { if (VAR == 6 || VAR == 7) break; asm volatile("s_waitcnt vmcnt(4)" ::: "memory"); __builtin_amdgcn_s_barrier(); asm volatile("" ::: "memory"); } while (0)

__device__ __forceinline__ void qkt(f32x16& p0, f32x16& p1, const LAS unsigned char* kb, const bf16x8 (&qf)[4]) {
    const f32x16 zero = {0.f, 0.f, 0.f, 0.f, 0.f, 0.f, 0.f, 0.f, 0.f, 0.f, 0.f, 0.f, 0.f, 0.f, 0.f, 0.f};
#pragma unroll
    for (int d0 = 0; d0 < 4; ++d0) {
        const bf16x8 a0 = *(const LAS bf16x8*)(kb + d0 * 2048), a1 = *(const LAS bf16x8*)(kb + d0 * 2048 + 512);
        if (d0 == 0) { p0 = __builtin_amdgcn_mfma_f32_32x32x16_bf16(a0, qf[0], zero, 0, 0, 0); p1 = __builtin_amdgcn_mfma_f32_32x32x16_bf16(a1, qf[0], zero, 0, 0, 0); }
        else { p0 = __builtin_amdgcn_mfma_f32_32x32x16_bf16(a0, qf[d0], p0, 0, 0, 0); p1 = __builtin_amdgcn_mfma_f32_32x32x16_bf16(a1, qf[d0], p1, 0, 0, 0); }
    }
}
__device__ __forceinline__ void band_mask(f32x16& p0, f32x16& p1, int lim, int hi) {
    int lim2 = lim - 4 * hi; asm volatile("" : "+v"(lim2));
#pragma unroll
    for (int r = 0; r < 16; ++r) { const int c = (r & 3) + 8 * (r >> 2); if (c > lim2) p0[r] = -INFINITY; if (c + 32 > lim2) p1[r] = -INFINITY; }
}
template <bool SHIFT> __device__ __forceinline__ void softmax_pack(f32x16& p0, f32x16& p1, float& lsum, bf16x8 (&pw)[4], float negM) {
#pragma unroll
    for (int r = 0; r < 16; ++r) { p0[r] = __builtin_amdgcn_exp2f(SHIFT ? p0[r] + negM : p0[r]); lsum += p0[r]; }
#pragma unroll
    for (int r = 0; r < 16; ++r) { p1[r] = __builtin_amdgcn_exp2f(SHIFT ? p1[r] + negM : p1[r]); lsum += p1[r]; }
    v4u w;
    w.x = cvtpk(p0[0], p0[1]); w.y = cvtpk(p0[2], p0[3]); w.z = cvtpk(p0[4], p0[5]); w.w = cvtpk(p0[6], p0[7]); pw[0] = __builtin_bit_cast(bf16x8, w);
    w.x = cvtpk(p0[8], p0[9]); w.y = cvtpk(p0[10], p0[11]); w.z = cvtpk(p0[12], p0[13]); w.w = cvtpk(p0[14], p0[15]); pw[1] = __builtin_bit_cast(bf16x8, w);
    w.x = cvtpk(p1[0], p1[1]); w.y = cvtpk(p1[2], p1[3]); w.z = cvtpk(p1[4], p1[5]); w.w = cvtpk(p1[6], p1[7]); pw[2] = __builtin_bit_cast(bf16x8, w);
    w.x = cvtpk(p1[8], p1[9]); w.y = cvtpk(p1[10], p1[11]); w.z = cvtpk(p1[12], p1[13]); w.w = cvtpk(p1[14], p1[15]); pw[3] = __builtin_bit_cast(bf16x8, w);
}
__device__ __forceinline__ void pv(f32x16 (&o)[4], const LAS unsigned char* vb, const bf16x8 (&pw)[4]) {
#pragma unroll
    for (int ks = 0; ks < 4; ++ks)
#pragma unroll
        for (int db = 0; db < 4; ++db) {
            const s16x4 lo = vtr(vb + db * 4096 + ks * 1024), hh = vtr(vb + db * 4096 + ks * 1024 + 512);
            const bf16x8 vf = (bf16x8){lo[0], lo[1], lo[2], lo[3], hh[0], hh[1], hh[2], hh[3]};
            o[db] = __builtin_amdgcn_mfma_f32_32x32x16_bf16(pw[ks], vf, o[db], 0, 0, 0);
        }
}

template <bool SHIFT, bool MASK, int VAR>
__device__ __forceinline__ void att_step(f32x16 (&o)[4], const v4u (&pin)[4], v4u (&pout)[4], float& lsum, const LAS unsigned char* kb, const LAS unsigned char* vb, const LAS unsigned char* vbn,
                                         s16x4 (&vl0)[4], s16x4 (&vh0)[4], const bf16x8 (&qf)[4], float negM, int lim, int hi) {
#define SBAR() __builtin_amdgcn_sched_barrier(0)
#define VOFF(m_) ((((m_) & 3) * 4096) + (((m_) >> 2) * 1024))
#define SOFTPAIR(j_) do { float e0, e1; if ((j_) < 8) { e0 = p0[2 * (j_)]; e1 = p0[2 * (j_) + 1]; } else { e0 = p1[2 * (j_) - 16]; e1 = p1[2 * (j_) - 15]; } \
        if (SHIFT) { e0 += negM; e1 += negM; } \
        if (VAR != 1) { e0 = __builtin_amdgcn_exp2f(e0); e1 = __builtin_amdgcn_exp2f(e1); lsum += e0; lsum += e1; pout[(j_) >> 2][(j_) & 3] = cvtpk(e0, e1); } \
        else { pout[(j_) >> 2][(j_) & 3] = __builtin_bit_cast(unsigned, e0) ^ __builtin_bit_cast(unsigned, e1); } } while (0)
    const f32x16 zero = {0.f, 0.f, 0.f, 0.f, 0.f, 0.f, 0.f, 0.f, 0.f, 0.f, 0.f, 0.f, 0.f, 0.f, 0.f, 0.f};
    bf16x8 kf[8];
#pragma unroll
    for (int d0 = 0; d0 < 4; ++d0) { kf[2 * d0] = *(const LAS bf16x8*)(kb + d0 * 2048); kf[2 * d0 + 1] = *(const LAS bf16x8*)(kb + d0 * 2048 + 512); }
    s16x4 vl[16], vh[16];
#pragma unroll
    for (int m = 0; m < 4; ++m) { vl[m] = vl0[m]; vh[m] = vh0[m]; }
#pragma unroll
    for (int m = 4; m < 8; ++m) { vl[m] = vtr(vb + VOFF(m)); vh[m] = vtr(vb + VOFF(m) + 512); }
    SBAR();
#pragma unroll
    for (int m = 0; m < 4; ++m) {
        const bf16x8 vf = (bf16x8){vl[m][0], vl[m][1], vl[m][2], vl[m][3], vh[m][0], vh[m][1], vh[m][2], vh[m][3]};
        if (VAR != 2) o[m & 3] = __builtin_amdgcn_mfma_f32_32x32x16_bf16(__builtin_bit_cast(bf16x8, pin[m >> 2]), vf, o[m & 3], 0, 0, 0); else asm volatile("" :: "v"(vf));
    }
    SBAR();
    f32x16 p0, p1;
    if (MASK) {
        p0 = __builtin_amdgcn_mfma_f32_32x32x16_bf16(kf[0], qf[0], zero, 0, 0, 0); p1 = __builtin_amdgcn_mfma_f32_32x32x16_bf16(kf[1], qf[0], zero, 0, 0, 0);
#pragma unroll
        for (int d0 = 1; d0 < 4; ++d0) { p0 = __builtin_amdgcn_mfma_f32_32x32x16_bf16(kf[2 * d0], qf[d0], p0, 0, 0, 0); p1 = __builtin_amdgcn_mfma_f32_32x32x16_bf16(kf[2 * d0 + 1], qf[d0], p1, 0, 0, 0); }
        band_mask(p0, p1, lim, hi);
        SBAR();
    } else {
        p0 = __builtin_amdgcn_mfma_f32_32x32x16_bf16(kf[0], qf[0], zero, 0, 0, 0);
#pragma unroll
        for (int d0 = 1; d0 < 4; ++d0) p0 = __builtin_amdgcn_mfma_f32_32x32x16_bf16(kf[2 * d0], qf[d0], p0, 0, 0, 0);
        SBAR();
        p1 = __builtin_amdgcn_mfma_f32_32x32x16_bf16(kf[1], qf[0], zero, 0, 0, 0); SOFTPAIR(0); SBAR();
        p1 = __builtin_amdgcn_mfma_f32_32x32x16_bf16(kf[3], qf[1], p1, 0, 0, 0); SOFTPAIR(1); SBAR();
        p1 = __builtin_amdgcn_mfma_f32_32x32x16_bf16(kf[5], qf[2], p1, 0, 0, 0); SOFTPAIR(2); SBAR();
        p1 = __builtin_amdgcn_mfma_f32_32x32x16_bf16(kf[7], qf[3], p1, 0, 0, 0); SOFTPAIR(3); SBAR();
    }
#pragma unroll
    for (int m = 4; m < 16; ++m) {
        if (m + 4 < 16) { if (VAR == 5 || VAR == 7) { vl[m + 4] = vl[m]; vh[m + 4] = vh[m]; } else { vl[m + 4] = vtr(vb + VOFF(m + 4)); vh[m + 4] = vtr(vb + VOFF(m + 4) + 512); } }
        else { vl0[m - 12] = vtr(vbn + VOFF(m - 12)); vh0[m - 12] = vtr(vbn + VOFF(m - 12) + 512); }
        const bf16x8 vf = (bf16x8){vl[m][0], vl[m][1], vl[m][2], vl[m][3], vh[m][0], vh[m][1], vh[m][2], vh[m][3]};
        if (VAR != 2) o[m & 3] = __builtin_amdgcn_mfma_f32_32x32x16_bf16(__builtin_bit_cast(bf16x8, pin[m >> 2]), vf, o[m & 3], 0, 0, 0); else asm volatile("" :: "v"(vf));
        if (MASK) { if (m < 8) { SOFTPAIR(2 * (m - 4)); SOFTPAIR(2 * (m - 4) + 1); } else { SOFTPAIR(m); } }
        else { SOFTPAIR(m); }
        SBAR();
    }
#undef SOFTPAIR
#undef VOFF
#undef SBAR
}

template <bool SHIFT, int VAR> __device__ __forceinline__ void attn_unit(LAS unsigned char* lds, const Par& P, int b, int head, int qb) {
    const int tid = threadIdx.x, lane = tid & 63, wid = __builtin_amdgcn_readfirstlane(tid >> 6), r32 = lane & 31, hi = lane >> 5, rg = wid >> 1, mp = wid & 1;
    const int i0 = qb * 128, iq = i0 + 32 * rg + r32;
    const int ntl = 2 * qb + 3, mylast = 2 * qb + 1 + (rg >= 2 ? 1 : 0);
    const GAS unsigned char* kg = (const GAS unsigned char*)(P.Kb + k_off(b, head, 0, 0, 0, 0)) + wid * 1024;
    const GAS unsigned char* vg = (const GAS unsigned char*)(P.Vb + v_off(b, head, 0, 0, 0, 0)) + wid * 1024;
    const unsigned l16 = (unsigned)lane * 16u;
    LAS unsigned char* ldw = lds + wid * 1024;
#define ATT_DMA(t_, slot_) do { if (VAR == 3 || VAR == 6 || VAR == 7) break; const size_t go_ = (VAR == 4) ? (size_t)0 : (size_t)(t_) * 16384; LAS unsigned char* d_ = ldw + (slot_) * 32768; \
        const GAS unsigned char* k_ = kg + go_; const GAS unsigned char* v_ = vg + go_; \
        dma16(k_, l16, d_); dma16(k_ + 8192, l16, d_ + 8192); dma16(v_, l16, d_ + 16384); dma16(v_ + 8192, l16, d_ + 24576); } while (0)
    ATT_DMA(0, 0); ATT_DMA(1, 1); ATT_DMA(2, 2);
    bf16x8 qf[4];
#pragma unroll
    for (int d0 = 0; d0 < 4; ++d0) qf[d0] = *(const GAS bf16x8*)(P.Qb + q_off(b, head, mp, i0 + 32 * rg, 2 * d0 + hi) + r32 * 8);
    f32x16 o[4]; const float negM = P.negM;
#pragma unroll
    for (int d = 0; d < 4; ++d)
#pragma unroll
        for (int r = 0; r < 16; ++r) o[d][r] = 0.f;
    float lsum = 0.f;
    const int koff = mp * 8192 + hi * 1024 + r32 * 16, voff = 16384 + ((lane >> 4) & 1) * 32 + (lane & 3) * 8 + (4 * hi + ((lane & 15) >> 2)) * 64;
    ATT_WAITBAR();
    bf16x8 pw0[4];
    {
        f32x16 p0, p1; qkt(p0, p1, lds + koff, qf);
#pragma unroll
        for (int r = 0; r < 16; ++r) { p0[r] = -INFINITY; if ((r & 3) + 8 * (r >> 2) < 16 - 4 * hi) p1[r] = -INFINITY; }
        softmax_pack<SHIFT>(p0, p1, lsum, pw0, negM);
    }
    if (wid >= 4) __builtin_amdgcn_s_setprio(1);
    int s_cur = 0, s_nxt = 1, s_nx2 = 2, s_fre = 3;
    v4u pw[4], pq[4];
#pragma unroll
    for (int i = 0; i < 4; ++i) pw[i] = __builtin_bit_cast(v4u, pw0[i]);
#define ATT_ROT4() do { const int x_ = s_cur; s_cur = s_nxt; s_nxt = s_nx2; s_nx2 = s_fre; s_fre = x_; } while (0)
#define ATT_KB (lds + s_nxt * 32768 + koff)
#define ATT_VB (lds + s_cur * 32768 + voff)
#define ATT_VBN (lds + s_nxt * 32768 + voff)
    s16x4 vl0[4], vh0[4];
#pragma unroll
    for (int m = 0; m < 4; ++m) { vl0[m] = vtr(ATT_VB + (m & 3) * 4096); vh0[m] = vtr(ATT_VB + (m & 3) * 4096 + 512); }
    int t = 0;
    for (; t < 2 * qb; t += 2) {
        att_step<SHIFT, false, VAR>(o, pw, pq, lsum, ATT_KB, ATT_VB, ATT_VBN, vl0, vh0, qf, negM, 0, hi); ATT_DMA(t + 3, s_fre); ATT_WAITBAR4(); ATT_ROT4();
        att_step<SHIFT, false, VAR>(o, pq, pw, lsum, ATT_KB, ATT_VB, ATT_VBN, vl0, vh0, qf, negM, 0, hi); ATT_DMA(t + 4, s_fre); ATT_WAITBAR4(); ATT_ROT4();
    }
    att_step<SHIFT, true, VAR>(o, pw, pq, lsum, ATT_KB, ATT_VB, ATT_VBN, vl0, vh0, qf, negM, iq - 64 * t, hi); ATT_WAITBAR(); ATT_ROT4(); ++t;
    att_step<SHIFT, true, VAR>(o, pq, pw, lsum, ATT_KB, ATT_VB, ATT_VBN, vl0, vh0, qf, negM, iq - 64 * t, hi); ATT_WAITBAR(); ATT_ROT4(); ++t;
    { bf16x8 pl[4];
#pragma unroll
      for (int i = 0; i < 4; ++i) pl[i] = __builtin_bit_cast(bf16x8, pw[i]);
      pv(o, ATT_VB, pl); }
    ATT_WAITBAR();
#undef ATT_ROT4
#undef ATT_KB
#undef ATT_VB
#undef ATT_VBN
#undef ATT_DMA
    __builtin_amdgcn_s_setprio(0);
    { auto rr = __builtin_amdgcn_permlane32_swap(__float_as_uint(lsum), __float_as_uint(lsum), false, false); lsum = __uint_as_float(rr[0]) + __uint_as_float(rr[1]); }
    int le = lane; asm volatile("" : "+v"(le));
    const int r32e = le & 31, hie = le >> 5;
    LAS float* lsc = (LAS float*)(lds + 135168) + wid * 32;
    LAS float* comb = (LAS float*)lds + rg * 4096 + (4 * hie) * 128 + r32e;
    if (hie == 0) lsc[r32e] = lsum;
    LDS_WAIT(); asm volatile("" ::: "memory");
    const float sc = mp ? P.lam : 1.0f;
#pragma unroll
    for (int r = 0; r < 16; ++r) { const float rl = sc / lsc[4 * hie + (r & 3) + 8 * (r >> 2)];
#pragma unroll
        for (int db = 0; db < 4; ++db) o[db][r] *= rl; }
    if (mp == 1) {
#pragma unroll
        for (int r = 0; r < 16; ++r)
#pragma unroll
            for (int db = 0; db < 4; ++db) comb[((r & 3) + 8 * (r >> 2)) * 128 + 32 * db] = o[db][r];
    }
    __syncthreads();
    if (mp == 0) {
        LAS unsigned short* yst = (LAS unsigned short*)(lds + 65536 + rg * 8192) + (4 * hie) * 128 + r32e;
        float sg[4];
#pragma unroll
        for (int db = 0; db < 4; ++db) sg[db] = P.subg[32 * db + r32e];
        const int x1 = (le ^ 1) << 2, x2 = (le ^ 2) << 2, x4 = (le ^ 4) << 2, x8 = (le ^ 8) << 2, x16 = (le ^ 16) << 2;
#pragma unroll
        for (int r = 0; r < 16; ++r) { float s = 0.f; const int qc = (r & 3) + 8 * (r >> 2);
#pragma unroll
            for (int db = 0; db < 4; ++db) { o[db][r] -= comb[qc * 128 + 32 * db]; s += o[db][r] * o[db][r]; }
            s += __builtin_bit_cast(float, __builtin_amdgcn_ds_bpermute(x1, __builtin_bit_cast(int, s))); s += __builtin_bit_cast(float, __builtin_amdgcn_ds_bpermute(x2, __builtin_bit_cast(int, s)));
            s += __builtin_bit_cast(float, __builtin_amdgcn_ds_bpermute(x4, __builtin_bit_cast(int, s))); s += __builtin_bit_cast(float, __builtin_amdgcn_ds_bpermute(x8, __builtin_bit_cast(int, s)));
            s += __builtin_bit_cast(float, __builtin_amdgcn_ds_bpermute(x16, __builtin_bit_cast(int, s)));
            s = rsqrtf(s * (1.0f / 128.0f) + EPS) * 0.8f;
#pragma unroll
            for (int db = 0; db < 4; ++db) yst[qc * 128 + 32 * db] = (unsigned short)f2bf(o[db][r] * s * sg[db]); }
        LDS_WAIT(); asm volatile("" ::: "memory");
        bf16* orow = P.mix + ((size_t)(b * SEQ + i0 + 32 * rg)) * DM + 512 + head * 128;
        const LAS unsigned short* ysr = (const LAS unsigned short*)(lds + 65536 + rg * 8192);
#pragma unroll
        for (int j = 0; j < 8; ++j) { const int q = 4 * j + (le >> 4), ch = le & 15;
            const v4u v = *(const LAS v4u*)(ysr + q * 128 + ch * 8);
            *(GAS v4u*)(orow + (size_t)q * DM + ch * 8) = v; }
    }
    __syncthreads();
}

__device__ __forceinline__ void attn_phase(Frame& F, const Args& a, unsigned char* ws) {
    const float* gq = a.in[5]; const float* gk = a.in[6];
    const float d1 = wave_sum(a.in[7][F.lane] * a.in[8][F.lane]), d2 = wave_sum(a.in[9][F.lane] * a.in[10][F.lane]);
    const float lam = __expf(d1) - __expf(d2) + 0.2f;
    const float mq = wave_max(fabsf(gq[F.lane])), mk = wave_max(fabsf(gk[F.lane]));
    Par P; P.Qb = (const bf16*)(ws + WS_Q); P.Kb = (const bf16*)(ws + WS_K); P.Vb = (const bf16*)(ws + WS_V); P.mix = (bf16*)(ws + WS_MIX); P.subg = a.in[11];
#if defined(ATT_VAR)
    if (a.ph_hi - a.ph_lo == 1) P.mix = (bf16*)(ws + WS_END);
#endif
    P.negM = -(8.0f * mq * mk * 1.4426950408889634f); P.lam = lam;
    const int nun = (F.G == 256) ? 4 : (1024 - F.vcu + F.G - 1) / F.G;
    for (int k = 0; k < nun; ++k) {
        int bh, qb;
        if (F.G == 256) { const int s_ = F.vcu & 15; bh = F.vcu >> 4; qb = (k == 0) ? s_ : (k == 1) ? 31 - s_ : (k == 2) ? 32 + s_ : 63 - s_; }
        else { const int uix = F.vcu + k * F.G; bh = uix >> 6; qb = uix & 63; }
#if defined(ATT_VAR)
        if (a.ph_hi - a.ph_lo == 1) { attn_unit<false, ATT_VAR>(F.lds, P, bh >> 2, bh & 3, qb); continue; }
#endif
        if (P.negM >= -100.0f) attn_unit<false, 0>(F.lds, P, bh >> 2, bh & 3, qb); else attn_unit<true, 0>(F.lds, P, bh >> 2, bh & 3, qb);
    }
}
}

typedef float f32x4v __attribute__((ext_vector_type(4)));
__device__ __forceinline__ void router_phase(Frame& F, const Args& a, unsigned char* ws) {
    const bf16* hb = (const bf16*)(ws + WS_XB); const f32x4* wrB = (const f32x4*)(ws + WS_WR); float* rstd2 = (float*)(ws + WS_RSTD2);
    const float* b_rg = a.in[15]; const float* b_re = a.in[17];
    int* rowpair = (int*)(ws + WS_ROWPAIR); float* rowrs = (float*)(ws + WS_ROWRS); unsigned* cnt = (unsigned*)(F.ctl + CW_CNT);
    LAS float* lgt = (LAS float*)(F.lds + 0);
    LAS int* pe = (LAS int*)(F.lds + 32768);
    LAS float* pg = (LAS float*)(F.lds + 32768 + 1024);
    LAS int* prk = (LAS int*)(F.lds + 32768 + 2048);
    LAS int* hist = (LAS int*)(F.lds + 32768 + 3072);
    const int lane = F.lane, w = F.wave;
    for (int blk = F.vcu; blk < NTOK / 128; blk += F.G) {
        if (F.tid < 64) hist[F.tid] = 0;
        if (w >= 4 && blk == F.vcu) expert_weight_copies(F, a, ws, F.vcu * 4 + (w - 4), F.G * 4, EWC_SPLIT, EWC_GU);
        if (w < 4) {
            const int tok0 = blk * 128 + 32 * w;
            typedef unsigned v2u __attribute__((ext_vector_type(2)));
            const GAS v2u* ap0 = (const GAS v2u*)(hb + (size_t)(tok0 + (lane & 15)) * DM) + (lane >> 4);
            const GAS v2u* ap1 = ap0 + 16 * (DM / 4);
            const GAS f32x4* bp = (const GAS f32x4*)wrB + lane;
            f32x4 acc[2][3]; float sq0 = 0.f, sq1 = 0.f;
#pragma unroll
            for (int r = 0; r < 2; ++r)
#pragma unroll
                for (int c = 0; c < 3; ++c) acc[r][c] = (f32x4){0.f, 0.f, 0.f, 0.f};
            v2u A0[4][2], A1[4][2]; f32x4 B0[4][3], B1[4][3];
#define RT_LDA(dst, bt) do { _Pragma("unroll") for (int j_ = 0; j_ < 4; ++j_) { dst[j_][0] = ap0[((bt) * 4 + j_) * 4]; dst[j_][1] = ap1[((bt) * 4 + j_) * 4]; } } while (0)
#define RT_LDB(dst, bt) do { _Pragma("unroll") for (int j_ = 0; j_ < 4; ++j_) _Pragma("unroll") for (int c_ = 0; c_ < 3; ++c_) dst[j_][c_] = bp[(((bt) * 4 + j_) * 3 + c_) * 64]; } while (0)
            RT_LDA(A0, 0); RT_LDB(B0, 0);
#pragma nounroll
            for (int bt = 0; bt < 16; ++bt) {
                const int b1 = bt + 1 < 16 ? bt + 1 : 15;
                RT_LDA(A1, b1); RT_LDB(B1, b1); __builtin_amdgcn_sched_barrier(0);
#pragma unroll
                for (int j = 0; j < 4; ++j) {
                    const v2u r0 = A0[j][0], r1 = A0[j][1];
                    const f32x4 a0 = {__builtin_bit_cast(float, r0.x << 16), __builtin_bit_cast(float, r0.x & 0xffff0000u), __builtin_bit_cast(float, r0.y << 16), __builtin_bit_cast(float, r0.y & 0xffff0000u)};
                    const f32x4 a1 = {__builtin_bit_cast(float, r1.x << 16), __builtin_bit_cast(float, r1.x & 0xffff0000u), __builtin_bit_cast(float, r1.y << 16), __builtin_bit_cast(float, r1.y & 0xffff0000u)};
                    const f32x4 b0 = B0[j][0], b1v = B0[j][1], b2v = B0[j][2];
                    sq0 += (a0[0] * a0[0] + a0[1] * a0[1]) + (a0[2] * a0[2] + a0[3] * a0[3]); sq1 += (a1[0] * a1[0] + a1[1] * a1[1]) + (a1[2] * a1[2] + a1[3] * a1[3]);
#pragma unroll
                    for (int c = 0; c < 4; ++c) {
                        acc[0][0] = __builtin_amdgcn_mfma_f32_16x16x4f32(a0[c], b0[c], acc[0][0], 0, 0, 0); acc[1][0] = __builtin_amdgcn_mfma_f32_16x16x4f32(a1[c], b0[c], acc[1][0], 0, 0, 0);
                        acc[0][1] = __builtin_amdgcn_mfma_f32_16x16x4f32(a0[c], b1v[c], acc[0][1], 0, 0, 0); acc[1][1] = __builtin_amdgcn_mfma_f32_16x16x4f32(a1[c], b1v[c], acc[1][1], 0, 0, 0);
                        acc[0][2] = __builtin_amdgcn_mfma_f32_16x16x4f32(a0[c], b2v[c], acc[0][2], 0, 0, 0); acc[1][2] = __builtin_amdgcn_mfma_f32_16x16x4f32(a1[c], b2v[c], acc[1][2], 0, 0, 0);
                    }
                }
                __builtin_amdgcn_sched_barrier(0);
#pragma unroll
                for (int j = 0; j < 4; ++j) { A0[j][0] = A1[j][0]; A0[j][1] = A1[j][1];
#pragma unroll
                    for (int c = 0; c < 3; ++c) B0[j][c] = B1[j][c]; }
            }
#undef RT_LDA
#undef RT_LDB
            sq0 += __shfl_xor(sq0, 16); sq0 += __shfl_xor(sq0, 32); sq1 += __shfl_xor(sq1, 16); sq1 += __shfl_xor(sq1, 32);
#pragma unroll
            for (int r = 0; r < 2; ++r)
#pragma unroll
                for (int c = 0; c < 3; ++c)
#pragma unroll
                    for (int q = 0; q < 4; ++q) lgt[(32 * w + 16 * r + 4 * (lane >> 4) + q) * 49 + 16 * c + (lane & 15)] = acc[r][c][q];
            if (lane < 16) { lgt[(32 * w + lane) * 49 + 48] = rsqrtf(sq0 * (1.0f / DM) + EPS); lgt[(32 * w + 16 + lane) * 49 + 48] = rsqrtf(sq1 * (1.0f / DM) + EPS); }
            LDS_WAIT(); asm volatile("" ::: "memory");
            if (lane < 32) {
                const int tl = 32 * w + lane; const LAS float* lg = lgt + tl * 49; const float rs = lg[48];
                rstd2[blk * 128 + tl] = rs;
                int gi = 0; float gl[4]; float gm; const f32x4 brg = *(const f32x4*)b_rg;
#pragma unroll
                for (int j = 0; j < 4; ++j) gl[j] = lg[j] * rs + brg[j];
                gm = gl[0];
#pragma unroll
                for (int j = 1; j < 4; ++j) if (gl[j] > gm) { gm = gl[j]; gi = j; }
                float gs = 0.f;
#pragma unroll
                for (int j = 0; j < 4; ++j) gs += __expf(gl[j] - gm);
                const float gval = 1.0f / gs;
                int e1 = 0, e2 = 0; float m1 = -INFINITY, m2 = -INFINITY;
                const f32x4 bre0 = *(const f32x4*)(b_re + gi * 8), bre1 = *(const f32x4*)(b_re + gi * 8 + 4);
#pragma unroll
                for (int j = 0; j < 8; ++j) { const float x = lg[4 + gi * 8 + j] * rs + (j < 4 ? bre0[j & 3] : bre1[j & 3]);
                    if (x > m1) { m2 = m1; e2 = e1; m1 = x; e1 = j; } else if (x > m2) { m2 = x; e2 = j; } }
                const float r = __expf(m2 - m1), g1v = gval / (1.0f + r), g2v = gval * r / (1.0f + r);
                pe[2 * tl] = gi * 8 + e1; pg[2 * tl] = g1v; pe[2 * tl + 1] = gi * 8 + e2; pg[2 * tl + 1] = g2v;
            }
        }
        __syncthreads();
        if (F.tid < 256) prk[F.tid] = atomicAdd((int*)&hist[pe[F.tid]], 1);
        __syncthreads();
        if (F.tid < 32) hist[32 + F.tid] = (int)__hip_atomic_fetch_add(cnt + 16 * F.tid, (unsigned)hist[F.tid], __ATOMIC_RELAXED, __HIP_MEMORY_SCOPE_AGENT);
        __syncthreads();
        if (F.tid < 256) { const int e = pe[F.tid], pos = hist[32 + e] + prk[F.tid];
            rowpair[(size_t)e * CAP + pos] = (int)((unsigned)(2 * (blk * 128 + (F.tid >> 1)) + (F.tid & 1)) | (f2bf(pg[F.tid]) << 16));
            rowrs[(size_t)e * CAP + pos] = lgt[(F.tid >> 1) * 49 + 48]; }
        __syncthreads();
    }
}

__device__ __forceinline__ MoeTab moe_tables(Frame& F, bool reuse) {
    LAS int* bs = (LAS int*)(F.lds + TAB_OFF); LAS int* cn = (LAS int*)(F.lds + TAB_OFF + 256);
    if (!reuse) {
        __syncthreads();
        if (F.tid < 64) {
            const int c = F.tid < 32 ? (int)__hip_atomic_load(F.ctl + CW_CNT + 16 * (F.tid & 31), RLX_AGENT) : 0; const int nb = (c + 255) >> 8; int s = nb;
#pragma unroll
            for (int o = 1; o < 32; o <<= 1) { const int v = __shfl_up(s, o); if ((F.tid & 63) >= o) s += v; }
            if (F.tid < 32) { cn[F.tid] = c; bs[F.tid] = s - nb; if (F.tid == 31) bs[NEXP] = s; }
        }
        __syncthreads();
    }
    MoeTab t; t.blkstart = bs; t.cnt = cn; return t;
}

__device__ __forceinline__ void combine_pass(Frame& F, const Args& a, unsigned char* ws) {
    typedef unsigned v2u_t __attribute__((ext_vector_type(2))); typedef float f2_t __attribute__((ext_vector_type(2)));
    float* out = a.out; const unsigned char* y = (const unsigned char*)(ws + WS_Y); const bf16* hb = (const bf16*)(ws + WS_XB);
    int tid_ = F.tid; asm volatile("" : "+v"(tid_));
    const int gt = F.vcu * (NWAVES * 64) + tid_, NGT = F.G * NWAVES * 64;
    constexpr int NIT = NTOK * (DM / 8), UNR = 4; constexpr float inv = 1.0f / Y8_SCALE;
    for (int it0 = gt; it0 < NIT; it0 += UNR * NGT) {
        v2u_t y0[UNR], y1[UNR]; v4u hv[UNR];
#pragma unroll
        for (int u = 0; u < UNR; ++u) { const int it = it0 + u * NGT; if (it < NIT) { const size_t tok = (size_t)(it >> 7); const int c0 = (it & 127) * 8;
            y0[u] = *(const GAS v2u_t*)(y + (2 * tok) * DM + c0); y1[u] = *(const GAS v2u_t*)(y + (2 * tok + 1) * DM + c0); hv[u] = *(const GAS v4u*)(hb + tok * DM + c0); } }
#pragma unroll
        for (int u = 0; u < UNR; ++u) { const int it = it0 + u * NGT; if (it < NIT) { const size_t tok = (size_t)(it >> 7); const int c0 = (it & 127) * 8;
            f32x4 h0, h1;
#pragma unroll
            for (int q = 0; q < 4; ++q) {
                const f2_t a2 = (q & 1) ? __builtin_amdgcn_cvt_pk_f32_fp8((int)y0[u][q >> 1], true) : __builtin_amdgcn_cvt_pk_f32_fp8((int)y0[u][q >> 1], false);
                const f2_t b2 = (q & 1) ? __builtin_amdgcn_cvt_pk_f32_fp8((int)y1[u][q >> 1], true) : __builtin_amdgcn_cvt_pk_f32_fp8((int)y1[u][q >> 1], false);
                const float lo = __builtin_bit_cast(float, hv[u][q] << 16) + (a2[0] + b2[0]) * inv, hi2 = __builtin_bit_cast(float, hv[u][q] & 0xffff0000u) + (a2[1] + b2[1]) * inv;
                if (q < 2) { h0[2 * q] = lo; h0[2 * q + 1] = hi2; } else { h1[2 * (q - 2)] = lo; h1[2 * (q - 2) + 1] = hi2; } }
            GAS f32x4* op = (GAS f32x4*)(out + tok * DM + c0); __builtin_nontemporal_store(h0, op); __builtin_nontemporal_store(h1, op + 1); } }
    }
}

constexpr int N_PHASES = 8;
#ifndef MK_SPLIT
#define MK_SPLIT 0
#endif
__device__ __forceinline__ Args load_args() {
#if defined(__HIP_DEVICE_COMPILE__)
    auto kp = __builtin_amdgcn_kernarg_segment_ptr(); asm volatile("" : "+s"(kp));
    typedef const __attribute__((address_space(4))) Args* CArgsP; const CArgsP ap = (CArgsP)kp; Args a;
#pragma unroll
    for (int i = 0; i < 21; ++i) a.in[i] = ap->in[i];
    a.out = ap->out; a.ws = ap->ws; a.ph_lo = ap->ph_lo; a.ph_hi = ap->ph_hi; return a;
#else
    return Args{};
#endif
}
__global__ void __launch_bounds__(NWAVES * 64, 2) hymba_fwd(Args args) {
    extern __shared__ __attribute__((aligned(16))) unsigned char lds[];
    Frame F;
    F.lds = (LAS unsigned char*)lds;
    F.MISC = (volatile LAS unsigned*)(F.lds + MISC_OFF);
    F.tid = threadIdx.x; F.lane = F.tid & 63; F.wave = __builtin_amdgcn_readfirstlane(F.tid >> 6);
    F.G = gridDim.x; { const int bx = blockIdx.x; F.vcu = (F.G % 8 == 0) ? (bx % 8) * (F.G / 8) + bx / 8 : bx; }
    unsigned char* ws = args.ws;
    F.ctl = (gu32*)(ws + WS_CTL);
    for (int u = F.tid; u < (LDS_BYTES - LDSCTL_OFF) / 4; u += NWAVES * 64) ((LAS unsigned*)(F.lds + LDSCTL_OFF))[u] = 0u;
    __syncthreads();
    const int lo = args.ph_lo, hi = args.ph_hi;
    XcdBarrier bar; bar.bar = (unsigned*)(F.ctl + CW_BAR); bar.x = 0; bar.st = nullptr;
    if (hi - lo > 1) bar = xcd_barrier_post((unsigned*)(F.ctl + CW_BAR), F.MISC + 8);
#ifndef PHASE_MASK
#define PHASE_MASK 0xff
#endif
#define IN(k) (((PHASE_MASK >> (k)) & 1) && lo <= (k) && (k) < hi)
#define SEAM(k) do { if (IN(k) && IN((k) + 1)) xcd_barrier(bar); } while (0)

    if (IN(0)) { const Args a0 = load_args(); p0_prologue(F, a0, ws); SEAM(0); }
#if defined(BAR_PROBE)
    if (hi - lo > 1) for (int i_ = 0; i_ < BAR_PROBE; ++i_) xcd_barrier(bar);
#endif

    if (IN(1)) {
        pg8::Gemm g{(const bf16*)(ws + WS_XB), (const bf16*)(ws + WS_WIN), MROWS, INCOLS, DM}; pg8::StaticOrder S; S.init(MROWS, INCOLS, F.G, (int)blockIdx.x);
#if defined(EPI_VAR)
        S.skip_epi = (EPI_VAR == 1) && (hi - lo == 1);
#endif
        const Args a1 = load_args();
        EpiInProj E{(bf16*)(ws + WS_CB), (bf16*)(ws + WS_CCX), (bf16*)(ws + WS_Q), (bf16*)(ws + WS_K), (bf16*)(ws + WS_V),
                    (const float*)(ws + WS_ROPEC), (const float*)(ws + WS_ROPES), a1.in[5], a1.in[6]};
        pg8::gemm_phase<EpiInProj, pg8::StaticOrder, true, false>(F.lds + RING_OFF, g, S, E);
        { const int nu = MROWS / 256 * (INCOLS / 256), heavy = nu % F.G;
          if ((int)blockIdx.x >= heavy) expert_weight_copies(F, a1, ws, ((int)blockIdx.x - heavy) * NWAVES + F.wave, (F.G - heavy) * NWAVES, 0, EWC_SPLIT); }
        SEAM(1);
    }

    if (IN(2)) {
#if defined(ATT_VAR)
        if (hi - lo != 1)
#endif
        { const Args a2 = load_args(); conv_pass(F, a2, ws); }
        { const Args a2 = load_args(); att::attn_phase(F, a2, ws); } SEAM(2); }

    if (IN(3)) {
        pg8::Gemm g{(const bf16*)(ws + WS_MIX), (const bf16*)(ws + WS_WOUT), NTOK, DM, DM}; pg8::StaticOrder S; S.init(NTOK, DM, F.G, (int)blockIdx.x);
#if defined(EPI_VAR)
        S.skip_epi = (EPI_VAR == 1) && (hi - lo == 1);
#endif
        EpiOutProj E{(bf16*)(ws + WS_XB), ws + WS_HQ, (const float*)(ws + WS_RSTD1)};
        pg8::gemm_phase<EpiOutProj, pg8::StaticOrder, true, false>(F.lds + RING_OFF, g, S, E);
        SEAM(3);
    }

    if (IN(4)) { const Args a4 = load_args(); router_phase(F, a4, ws); SEAM(4); }

    if (IN(5)) {
        const MoeTab tb = moe_tables(F, false);
        MoeOrderT<false> S{F.G, (int)blockIdx.x, 4 * tb.blkstart[NEXP], DM  , tb, (const int*)(ws + WS_ROWPAIR)};
#if defined(EPI_VAR)
        S.skip_epi = (EPI_VAR == 1) && (hi - lo == 1);
#endif
        pg8::Gemm g{(const bf16*)(ws + WS_HQ), (const bf16*)(ws + WS_WGU), 0, NEXP * 1024, DM};
        EpiMoe1 E{tb, (const float*)(ws + WS_ROWRS), ws + WS_HID};
        pg8::gemm_phase<EpiMoe1, MoeOrderT<false>, true, true, true>(F.lds + RING_OFF, g, S, E);
        { const int r5 = S.nunits % F.G;
          if ((int)blockIdx.x >= r5) { const Args a5 = load_args(); expert_weight_copies(F, a5, ws, ((int)blockIdx.x - r5) * NWAVES + F.wave, (F.G - r5) * NWAVES, EWC_GU, EWC_ITEMS); } }
        SEAM(5);
    }

    if (IN(6)) {
        const MoeTab tb = moe_tables(F, IN(5));
        MoeOrderT<true> S{F.G, (int)blockIdx.x, 4 * tb.blkstart[NEXP], DFF  , tb, (const int*)(ws + WS_ROWPAIR)};
#if defined(EPI_VAR)
        S.skip_epi = (EPI_VAR == 1) && (hi - lo == 1);
#endif
        pg8::Gemm g{(const bf16*)(ws + WS_HID), (const bf16*)(ws + WS_WD), 0, NEXP * DM, DFF};
        EpiMoe2 E{tb, (const int*)(ws + WS_ROWPAIR), (bf16*)(ws + WS_Y)};
        pg8::gemm_phase<EpiMoe2, MoeOrderT<true>, true, true, true>(F.lds + RING_OFF, g, S, E);
        SEAM(6);
    }

    if (IN(7)) { const Args a7 = load_args(); combine_pass(F, a7, ws); }
#undef IN
#undef SEAM
}

extern "C" void kernel_launch(void* const* d_in, const int* in_sizes, int n_in, void* d_out, int out_size, void* d_ws, size_t ws_size, hipStream_t stream) {
    static int grid = 0;
    if (grid == 0) {
        if (n_in != 21 || in_sizes[0] != NTOK * DM || out_size != NTOK * DM || ws_size < WS_NEED) { fprintf(stderr, "kernel_launch: unexpected shapes (n_in %d, in0 %d, out %d, ws %zu)\n", n_in, n_in > 0 ? in_sizes[0] : -1, out_size, ws_size); grid = -1; return; }
        int dev = 0, cus = 0, per_cu = 0;
        if (hipGetDevice(&dev) != hipSuccess || hipDeviceGetAttribute(&cus, hipDeviceAttributeMultiprocessorCount, dev) != hipSuccess) { grid = -1; return; }
        if (hipFuncSetAttribute((const void*)hymba_fwd, hipFuncAttributeMaxDynamicSharedMemorySize, LDS_BYTES) != hipSuccess) { fprintf(stderr, "kernel_launch: hipFuncSetAttribute failed\n"); grid = -1; return; }
        if (hipOccupancyMaxActiveBlocksPerMultiprocessor(&per_cu, (const void*)hymba_fwd, NWAVES * 64, LDS_BYTES) != hipSuccess || per_cu < 1) { fprintf(stderr, "kernel_launch: occupancy query says %d\n", per_cu); (void)hipGetLastError(); grid = -1; return; }
        grid = cus;
    }
    if (grid < 0) return;
    if (hipMemsetAsync((char*)d_ws + WS_CTL, 0, CTL_ZERO_BYTES, stream) != hipSuccess) return;
    Args a{};
    for (int i = 0; i < 21; ++i) a.in[i] = (const float*)d_in[i];
    a.out = (float*)d_out; a.ws = (unsigned char*)d_ws;
#if defined(REP_MASK)
    { int k = 0; while (!((REP_MASK >> k) & 1)) ++k;
      a.ph_lo = 0; a.ph_hi = k + 1; hipLaunchKernelGGL(hymba_fwd, dim3(grid), dim3(NWAVES * 64), LDS_BYTES, stream, a);
      if (hipMemsetAsync((char*)d_ws + WS_CTL + CW_BAR * 4, 0, XCD_BAR_WORDS * 4, stream) != hipSuccess) return;
      a.ph_lo = k; a.ph_hi = k + 1; hipLaunchKernelGGL(hymba_fwd, dim3(grid), dim3(NWAVES * 64), LDS_BYTES, stream, a);
      if (k + 1 < N_PHASES) { a.ph_lo = k + 1; a.ph_hi = N_PHASES; hipLaunchKernelGGL(hymba_fwd, dim3(grid), dim3(NWAVES * 64), LDS_BYTES, stream, a); } }
#elif MK_SPLIT
    for (int p = 0; p < N_PHASES; ++p) { a.ph_lo = p; a.ph_hi = p + 1; hipLaunchKernelGGL(hymba_fwd, dim3(grid), dim3(NWAVES * 64), LDS_BYTES, stream, a); }
#else
    a.ph_lo = 0; a.ph_hi = N_PHASES;
    hipLaunchKernelGGL(hymba_fwd, dim3(grid), dim3(NWAVES * 64), LDS_BYTES, stream, a);
#endif
}
```

```cpp
#include <hip/hip_runtime.h>
#include <cstdio>
#include <cstdint>
#include <cmath>

#define HD_INL __host__ __device__ __forceinline__
#define GAS __attribute__((address_space(1)))
#define LAS __attribute__((address_space(3)))
typedef unsigned short bf16;
typedef unsigned v4u __attribute__((ext_vector_type(4)));
typedef float f32x4 __attribute__((ext_vector_type(4)));
typedef float f32x16 __attribute__((ext_vector_type(16)));
typedef short bf16x8 __attribute__((ext_vector_type(8)));
typedef short s16x4 __attribute__((ext_vector_type(4)));
typedef GAS unsigned gu32;
#define RLX_AGENT __ATOMIC_RELAXED, __HIP_MEMORY_SCOPE_AGENT
#define LDS_WAIT() asm volatile("s_waitcnt lgkmcnt(0)" ::: "memory")
#define VM_WAIT() asm volatile("s_waitcnt vmcnt(0)" ::: "memory")

constexpr int DM = 1024, BATCH = 4, SEQ = 8192, NMETA = 16;
constexpr int NTOK = BATCH * SEQ;
constexpr int MROWS = NTOK + 256;
constexpr int CONVW = 512, NHEAD = 4, HDIM = 64, VDIM = 128, INCOLS = 3072;
constexpr int NEXP = 32, DFF = 512, NGRP = 4, EPG = 8;
constexpr int KVT = SEQ / 64 + 1;
constexpr int CCXROWS = SEQ + 2;
constexpr int CAP = NTOK;
constexpr float EPS = 1e-6f;
constexpr float QSCALE = 0.125f * 1.4426950408889634f;

constexpr size_t MiB = 1u << 20;
constexpr size_t WS_CTL = 0, CTL_ZERO_BYTES = 128 * 1024;
constexpr size_t WS_RSTD1 = 1 * MiB, WS_RSTD2 = 1 * MiB + 512 * 1024, WS_ROPEC = 2 * MiB, WS_ROPES = 2 * MiB + 512 * 1024, WS_WR = 3 * MiB, WS_MISCF = 3 * MiB + 512 * 1024;
constexpr size_t WS_WIN = 4 * MiB, WS_WOUT = 10 * MiB, WS_WGU = 12 * MiB  , WS_HQ = 44 * MiB  , WS_WD = 76 * MiB  ;
constexpr float F8S_H = 8.0f, F8S_W = 256.0f, F8S_HID = 4.0f;
constexpr size_t WS_ROWPAIR = 108 * MiB, WS_ROWRS = 112 * MiB;
constexpr size_t WS_XB = 116 * MiB;
constexpr size_t WS_MIX = 181 * MiB;
constexpr size_t WS_Y = 342 * MiB;
constexpr size_t WS_CB = 245 * MiB, WS_CCX = 277 * MiB, WS_Q = 310 * MiB;
constexpr size_t WS_HID = 245 * MiB;
constexpr size_t WS_K = 342 * MiB, WS_V = 375 * MiB, WS_END = 408 * MiB  , WS_NEED = 472 * MiB;
static_assert(WS_XB + (size_t)MROWS * DM * 2 <= WS_MIX && WS_Y + (size_t)2 * NTOK * DM * 2 <= WS_NEED && WS_Y >= WS_HID + (size_t)288 * 256 * DFF * 2 && WS_HID + (size_t)288 * 256 * DFF * 2 <= WS_K, "ws map");
static_assert(WS_WGU + (size_t)NEXP * 1024 * DM <= WS_HQ && WS_HQ + (size_t)NTOK * DM <= WS_WD && WS_WD + (size_t)NEXP * DM * DFF <= WS_ROWPAIR, "ws map 3");
static_assert(WS_CCX + (size_t)BATCH * CCXROWS * CONVW * 2 <= WS_Q && WS_K + (size_t)BATCH * NHEAD * KVT * 16384 <= WS_V && WS_V + (size_t)BATCH * NHEAD * KVT * 16384 <= WS_END, "ws map 2");
constexpr int CW_TMO = 0, CW_CODE = 1, CW_ERR = 16  , CW_BAR = 4096, CW_CNT = 16384  , CW_RDY = 20480  ;

HD_INL int qk_delta(int chunk, int e) { const int bj = chunk >> 2, fq = chunk & 3; if (bj == 0 && fq < 2) return e < 4 ? 4 * fq + e : 8 + 4 * fq + (e - 4); return bj == 0 ? 8 * fq + e : 32 + 8 * fq + e; }
HD_INL size_t q_off(int b, int head, int mp, int i, int chunk) { return ((((size_t)(b * 4 + head) * 2 + mp) * 256 + (i >> 5)) * 8 + chunk) * 256 + (size_t)(i & 31) * 8; }
HD_INL size_t k_off(int b, int head, int t, int mp, int chunk, int row) { return (((size_t)(b * 4 + head) * KVT + t) * 2 + mp) * 4096 + (size_t)chunk * 512 + (size_t)row * 8; }
HD_INL size_t v_off(int b, int head, int t, int dq, int row, int dcol) { return ((size_t)(b * 4 + head) * KVT + t) * 8192 + (size_t)dq * 2048 + (size_t)(row >> 4) * 512 + (size_t)(row & 15) * 32 + dcol; }
HD_INL int inproj_col(int n) {
    const int pn = n >> 8, p = n & 255, bj = p >> 7, x = p & 127;
    if (pn < 2 || pn >= 10) return n;
    if (pn < 6) return (bj ? 1024 : 512) + 128 * (pn - 2) + x;
    const int wc = x >> 5, fq = (x >> 3) & 3, e = x & 7;
    return 1536 + 256 * (pn - 6) + 64 * wc + qk_delta(4 * bj + fq, e);
}

namespace pg8 {
#define PG8_LAS __attribute__((address_space(3)))
typedef unsigned short bf16_t;
typedef unsigned u32x4 __attribute__((ext_vector_type(4)));
typedef int i32x4 __attribute__((ext_vector_type(4)));
typedef int i32x8 __attribute__((ext_vector_type(8)));
constexpr int BM = 256, BK = 64, HALF = 128, HTB = HALF * BK * 2  , STAGE_BYTES = 8 * HTB, NXCD = 8, WGM = 8;

__host__ __device__ __forceinline__ int lds_byte(int r, int c) { const int st = (r >> 4) * 2 + (c >> 5), rr = r & 15, cc = c & 31, ob = rr * 64 + cc * 2; return st * 1024 + (ob ^ (((ob >> 9) & 1) << 5)); }
__host__ __device__ __forceinline__ void stage_rc(int b, int& R, int& C) { const int st = b / 1024, sb = b % 1024, swz = sb ^ (((sb >> 9) & 1) << 5); R = (st >> 1) * 16 + swz / 64; C = (st & 1) * 32 + (swz % 64) / 2; }
__host__ __device__ __forceinline__ int perm32(int rho) { const int n = rho >> 4, i = rho & 15; return 8 * (i >> 2) + 4 * n + (i & 3); }

struct Unit { int pm, pn; };
struct Gemm { const bf16_t* A; const bf16_t* Bt; int M, N, K; };

struct StaticOrder {
    int nM, nN, nwg, G, c;
    __host__ __device__ void init(int M, int N, int G_, int c_) { nM = M / BM; nN = N / BM; nwg = nM * nN; G = G_; c = c_; }
    __host__ __device__ bool next(int i, Unit& u) const {
        const long L = (long)i * G + c; if (L >= nwg) return false;
        int wgid = (int)L; { const int q = nwg / NXCD, r = nwg % NXCD, xcd = wgid % NXCD, off = wgid / NXCD; wgid = (xcd < r ? xcd * (q + 1) : r * (q + 1) + (xcd - r) * q) + off; }
        const int nig = WGM * nN, gid = wgid / nig, fm = gid * WGM, gsz = (nM - fm) < WGM ? (nM - fm) : WGM;
        u.pm = fm + ((wgid % nig) % gsz); u.pn = (wgid % nig) / gsz; return true;
    }
    __device__ __forceinline__ unsigned arow_raw(const Unit&, int) const { return 0u; }
    __device__ __forceinline__ unsigned arow_fin(unsigned) const { return 0u; }
#if defined(EPI_VAR)
    bool skip_epi = false; __device__ __forceinline__ bool probe_skip_epi() const { return skip_epi; }
#endif
};

__device__ __forceinline__ unsigned cvt_pk_bf16(float lo, float hi) { unsigned r; asm volatile("v_cvt_pk_bf16_f32 %0, %1, %2" : "=v"(r) : "v"(lo), "v"(hi)); return r; }
__device__ __forceinline__ u32x4 pack8(const f32x4 a, const f32x4 b) { u32x4 w; w.x = cvt_pk_bf16(a[0], a[1]); w.y = cvt_pk_bf16(a[2], a[3]); w.z = cvt_pk_bf16(b[0], b[1]); w.w = cvt_pk_bf16(b[2], b[3]); return w; }

template <class Epi, class Sched, bool ALIGN_EPI, bool GATHER, bool FP8 = false>
__device__ __forceinline__ void gemm_phase(PG8_LAS unsigned char* lds, const Gemm g, const Sched& S, const Epi& E) {
    const int tid = threadIdx.x, wid = __builtin_amdgcn_readfirstlane(tid >> 6), lane = tid & 63, wr = wid >> 2, wc = wid & 3, fr = lane & 15, fq = lane >> 4;
    const int KB = FP8 ? g.K : g.K * 2, nt = KB / (BK * 2);
    unsigned voffA[2], voffB[2];
#pragma unroll
    for (int i = 0; i < 2; ++i) { int R, C; stage_rc(tid * 16 + i * 8192, R, C);
        const int Rb = Epi::WIDEB ? (64 * (R >> 5) + 16 * ((R & 15) >> 2) + 4 * ((R >> 4) & 1) + (R & 3)) : (Epi::PERM ? ((R & ~31) + perm32(R & 31)) : R);
        voffA[i] = (unsigned)(R * KB + C * 2); voffB[i] = (unsigned)(Rb * KB + C * 2); }
    const size_t kstep = (size_t)(BK * 2);
    const size_t hstep = (size_t)HALF * KB;
    const size_t tstep = 2 * hstep;
    const size_t bhs = Epi::WIDEB ? (size_t)8 * KB : hstep;
    const unsigned ldsw = (unsigned)wid * 1024u;
    const int aoff = lds_byte(wr * 64 + fr, fq * 8), boff = lds_byte(wc * 32 + fr, fq * 8);
    unsigned cvo[2][2], nvo[2][2];
#define PG8_SA(b, h) (((b) * 2 + (h)) * HTB)
#define PG8_SB(b, h) ((4 + (b) * 2 + (h)) * HTB)
#define PG8_STAGE(bufoff, gbase, voff) do { _Pragma("unroll") for (int _i = 0; _i < 2; ++_i) \
        __builtin_amdgcn_global_load_lds((const unsigned*)((const char*)(gbase) + (voff)[_i]), (PG8_LAS unsigned*)(lds + (bufoff) + ldsw + _i * 8192), 16, 0, 0); } while (0)
#define PG8_STGA(bufoff, gbase, hh, USE_NEXT) do { if constexpr (GATHER) { _Pragma("unroll") for (int _i = 0; _i < 2; ++_i) { \
        __builtin_amdgcn_global_load_lds((const unsigned*)((const char*)(gbase) + cvo[hh][_i]), (PG8_LAS unsigned*)(lds + (bufoff) + ldsw + _i * 8192), 16, 0, 0); } } \
        else { PG8_STAGE(bufoff, (gbase) + (hh) * hstep, voffA); } } while (0)
#define PG8_LDA(dst, b, h) do { _Pragma("unroll") for (int m = 0; m < 4; ++m) _Pragma("unroll") for (int k = 0; k < 2; ++k) dst[m][k] = *(const PG8_LAS bf16x8*)(lds + PG8_SA(b, h) + aoff + m * 2048 + k * 1024); } while (0)
#define PG8_LDB(dst, b, h) do { _Pragma("unroll") for (int n = 0; n < 2; ++n) _Pragma("unroll") for (int k = 0; k < 2; ++k) dst[n][k] = *(const PG8_LAS bf16x8*)(lds + PG8_SB(b, h) + boff + n * 2048 + k * 1024); } while (0)
#define PG8_SC mxsc
#define PG8_CAT8(x) __builtin_shufflevector(__builtin_bit_cast(i32x4, (x)[0]), __builtin_bit_cast(i32x4, (x)[1]), 0, 1, 2, 3, 4, 5, 6, 7)
#define PG8_MMA(ai, bj, At, Bt) do { __builtin_amdgcn_s_setprio(1); if constexpr (FP8) { _Pragma("unroll") for (int m = 0; m < 4; ++m) _Pragma("unroll") for (int n = 0; n < 2; ++n) \
        acc[ai][bj][m][n] = __builtin_amdgcn_mfma_scale_f32_16x16x128_f8f6f4(PG8_CAT8(Bt[n]), PG8_CAT8(At[m]), acc[ai][bj][m][n], 0, 0, 0, PG8_SC, 0, PG8_SC); } \
      else { _Pragma("unroll") for (int m = 0; m < 4; ++m) _Pragma("unroll") for (int n = 0; n < 2; ++n) _Pragma("unroll") for (int k = 0; k < 2; ++k) \
        acc[ai][bj][m][n] = __builtin_amdgcn_mfma_f32_16x16x32_bf16(Bt[n][k], At[m][k], acc[ai][bj][m][n], 0, 0, 0); } __builtin_amdgcn_s_setprio(0); } while (0)
#define PG8_WAIT_V(n) asm volatile("s_waitcnt vmcnt(" #n ")" ::: "memory")
#define PG8_WAIT_L(n) asm volatile("s_waitcnt lgkmcnt(" #n ")" ::: "memory")
#define PG8_BAR __builtin_amdgcn_s_barrier()
#define PG8_SCHED __builtin_amdgcn_sched_barrier(0)
#define PG8_GRAW(dst, un) do { if constexpr (GATHER) { _Pragma("unroll") for (int _i = 0; _i < 2; ++_i) { int R_, C_; stage_rc(tid * 16 + _i * 8192, R_, C_); \
        _Pragma("unroll") for (int _h = 0; _h < 2; ++_h) dst[_h][_i] = S.arow_raw(un, _h * HALF + R_); } } } while (0)
#define PG8_GFIN(dst, src) do { if constexpr (GATHER) { _Pragma("unroll") for (int _i = 0; _i < 2; ++_i) { int R_, C_; stage_rc(tid * 16 + _i * 8192, R_, C_); \
        _Pragma("unroll") for (int _h = 0; _h < 2; ++_h) dst[_h][_i] = S.arow_fin(src[_h][_i]) + (unsigned)C_ * 2u; } } } while (0)
    int mxsc = 0; if constexpr (FP8) asm volatile("s_mov_b32 %0, 0x7f7f7f7f" : "=s"(mxsc));
    Unit cur, nxt; int ui = 0;
    if (!S.next(0, cur)) return;
    f32x4 acc[2][2][4][2];
#pragma unroll
    for (int a = 0; a < 2; ++a)
#pragma unroll
        for (int b = 0; b < 2; ++b)
#pragma unroll
            for (int m = 0; m < 4; ++m)
#pragma unroll
                for (int n = 0; n < 2; ++n) acc[a][b][m][n] = (f32x4){0.f, 0.f, 0.f, 0.f};
    bf16x8 At[4][2], B0[2][2], B1[2][2];
    const char* cA = GATHER ? (const char*)g.A : (const char*)g.A + (size_t)cur.pm * tstep; const char* cB = (const char*)g.Bt + (size_t)cur.pn * tstep;
    PG8_GRAW(nvo, cur); PG8_GFIN(cvo, nvo);
    typename Epi::Meta meta = E.prefetch(cur, wr, fr);
    PG8_STAGE(PG8_SB(0, 0), cB, voffB); PG8_STAGE(PG8_SB(0, 1), cB + bhs, voffB); PG8_STGA(PG8_SA(0, 0), cA, 0, false); PG8_STGA(PG8_SA(0, 1), cA, 1, false);
    if (wr == 1) PG8_BAR;
    PG8_WAIT_V(2); PG8_BAR;
    PG8_STAGE(PG8_SB(1, 0), cB + kstep, voffB); PG8_STGA(PG8_SA(1, 0), cA + kstep, 0, false); PG8_STAGE(PG8_SB(1, 1), cB + bhs + kstep, voffB);
    PG8_WAIT_V(6); PG8_BAR;
    for (;;) {
        const bool has_next = S.next(ui + 1, nxt);
        if constexpr (GATHER) { if (has_next) PG8_GRAW(nvo, nxt); }
        const char* nA = GATHER ? (const char*)g.A : (has_next ? (const char*)g.A + (size_t)nxt.pm * tstep : cA); const char* nB = has_next ? (const char*)g.Bt + (size_t)nxt.pn * tstep : cB;
#pragma nounroll
        for (int t = 0; t < nt; t += 2) {
            const bool last = (t == nt - 2);
            const char* a1 = cA + (size_t)(t + 1) * kstep;
            const char* a2 = last ? nA : cA + (size_t)(t + 2) * kstep; const char* b2 = last ? nB : cB + (size_t)(t + 2) * kstep;
            const char* a3 = a2 + kstep; const char* b3 = b2 + kstep;
            PG8_LDB(B0, 0, 0); PG8_LDB(B1, 0, 1); PG8_SCHED; PG8_LDA(At, 0, 0); PG8_STGA(PG8_SA(1, 1), a1, 1, false);
            if constexpr (GATHER) { if (last && has_next) { asm volatile("" : "+v"(nvo[0][0]), "+v"(nvo[0][1]), "+v"(nvo[1][0]), "+v"(nvo[1][1])); PG8_GFIN(cvo, nvo); } }
            PG8_WAIT_V(8); PG8_WAIT_L(0); PG8_BAR; PG8_MMA(0, 0, At, B0); PG8_MMA(0, 1, At, B1); PG8_BAR; PG8_SCHED;
            PG8_LDA(At, 0, 1); PG8_STAGE(PG8_SB(0, 0), b2, voffB); PG8_STAGE(PG8_SB(0, 1), b2 + bhs, voffB); PG8_STGA(PG8_SA(0, 0), a2, 0, last);
            PG8_WAIT_V(8); PG8_WAIT_L(0); PG8_BAR; PG8_MMA(1, 0, At, B0); PG8_MMA(1, 1, At, B1); PG8_BAR; PG8_SCHED;
            PG8_LDB(B0, 1, 0); PG8_LDB(B1, 1, 1); PG8_SCHED; PG8_LDA(At, 1, 0); PG8_STGA(PG8_SA(0, 1), a2, 1, last);
            PG8_WAIT_V(8); PG8_WAIT_L(0); PG8_BAR; PG8_MMA(0, 0, At, B0); PG8_MMA(0, 1, At, B1); PG8_BAR; PG8_SCHED;
            PG8_LDA(At, 1, 1); PG8_STAGE(PG8_SB(1, 0), b3, voffB); PG8_STAGE(PG8_SB(1, 1), b3 + bhs, voffB); PG8_STGA(PG8_SA(1, 0), a3, 0, last);
            PG8_WAIT_V(8); PG8_WAIT_L(0); PG8_BAR; PG8_MMA(1, 0, At, B0); PG8_MMA(1, 1, At, B1); PG8_BAR; PG8_SCHED;
        }
        if constexpr (ALIGN_EPI) { if (wr == 0) PG8_BAR; }
#if defined(EPI_VAR)
        if (S.probe_skip_epi()) { _Pragma("unroll") for (int a_ = 0; a_ < 2; ++a_) _Pragma("unroll") for (int b_ = 0; b_ < 2; ++b_) _Pragma("unroll") for (int m_ = 0; m_ < 4; ++m_) asm volatile("" :: "v"(acc[a_][b_][m_][0]), "v"(acc[a_][b_][m_][1])); } else
#endif
        E(acc, cur, wr, wc, fr, fq, meta);
        if (!has_next) break;
#pragma unroll
        for (int a = 0; a < 2; ++a)
#pragma unroll
            for (int b = 0; b < 2; ++b)
#pragma unroll
                for (int m = 0; m < 4; ++m)
#pragma unroll
                    for (int n = 0; n < 2; ++n) acc[a][b][m][n] = (f32x4){0.f, 0.f, 0.f, 0.f};
        cur = nxt; cA = nA; cB = nB; ++ui;
        meta = E.prefetch(cur, wr, fr);
        if constexpr (ALIGN_EPI) { if (wr == 1) PG8_BAR; }
    }
    PG8_WAIT_V(0);
    if constexpr (!ALIGN_EPI) { if (wr == 0) PG8_BAR; }
    PG8_BAR;
#undef PG8_SA
#undef PG8_SB
#undef PG8_STAGE
#undef PG8_STGA
#undef PG8_LDA
#undef PG8_LDB
#undef PG8_MMA
#undef PG8_CAT8
#undef PG8_SC
#undef PG8_WAIT_V
#undef PG8_WAIT_L
#undef PG8_BAR
#undef PG8_SCHED
#undef PG8_GRAW
#undef PG8_GFIN
}
}
__device__ __forceinline__ unsigned long long rt() { return __builtin_amdgcn_s_memrealtime(); }
__device__ __forceinline__ unsigned f2bf(float f) { unsigned u = __builtin_bit_cast(unsigned, f); return (u + 0x7fffu + ((u >> 16) & 1u)) >> 16; }
__device__ __forceinline__ unsigned pk2(float lo, float hi) { return f2bf(lo) | (f2bf(hi) << 16); }
#define XB_TMO      128
#define XB_XCNT(j)  (256  + 64 * (j))
#define XB_XSUB(j)  (1280 + 64 * (j))
#define XB_XGEN(j)  (2304 + 64 * (j))
#define XB_TOP      3328
#define XB_TOPGEN   3392
#define XCD_BAR_WORDS 3456
#define XB_SPIN_CAP (1u << 18)

__device__ __forceinline__ unsigned xb_ld(unsigned* p)              { return __hip_atomic_load(p, __ATOMIC_RELAXED, __HIP_MEMORY_SCOPE_AGENT); }
__device__ __forceinline__ unsigned xb_add(unsigned* p, unsigned v) { return __hip_atomic_fetch_add(p, v, __ATOMIC_RELAXED, __HIP_MEMORY_SCOPE_AGENT); }
__device__ __forceinline__ unsigned xb_xcc_id() { return (unsigned)__builtin_amdgcn_s_getreg((3 << 11) | 20) & 0xFu; }
#define XB_SPIN(cond, bar) do { unsigned _sp = 0; while (cond) { __builtin_amdgcn_s_sleep(1); \
    if ((++_sp & 255u) == 0u) { if (xb_ld(&(bar)[XB_TMO])) break; if (_sp > XB_SPIN_CAP) { atomicAdd(&(bar)[XB_TMO], 1u); break; } } } } while (0)

struct XcdBarrier {
    unsigned* bar; unsigned x;
    volatile LAS unsigned* st;
};

__device__ __forceinline__ XcdBarrier xcd_barrier_post(unsigned* bar, volatile LAS unsigned* st) {
    XcdBarrier b; b.bar = bar; b.x = xb_xcc_id(); b.st = st;
    if (threadIdx.x == 0) (void)xb_add(&bar[XB_XCNT(b.x)], 1u);
    return b;
}
__device__ __forceinline__ void xcd_barrier_complete(unsigned* bar, unsigned x, unsigned& nloc, unsigned& nx) {
    const unsigned G = gridDim.x * gridDim.y * gridDim.z;
    unsigned sum, cnt, mine, sp = 0u;
    for (;;) {
        sum = 0u; cnt = 0u; mine = 0u;
#pragma unroll
        for (unsigned j = 0; j < 16; ++j) { const unsigned c = xb_ld(&bar[XB_XCNT(j)]); sum += c; cnt += (c > 0u) ? 1u : 0u; mine = (j == x) ? c : mine; }
        if (sum == G) break;
        __builtin_amdgcn_s_sleep(1);
        if ((++sp & 255u) == 0u) { if (xb_ld(&bar[XB_TMO])) break; if (sp > XB_SPIN_CAP) { atomicAdd(&bar[XB_TMO], 1u); break; } }
    }
    nloc = mine > 0u ? mine : 1u; nx = cnt > 0u ? cnt : 1u;
}

__device__ __forceinline__ void xcd_barrier(const XcdBarrier& b) {
    asm volatile("s_waitcnt vmcnt(0)" ::: "memory");
    __syncthreads();
    if (threadIdx.x == 0) {
        unsigned* bar = b.bar;
        __builtin_amdgcn_s_waitcnt(0);
        unsigned nloc = b.st[0], nx = b.st[1];
        if (nloc == 0u) { xcd_barrier_complete(bar, b.x, nloc, nx); b.st[0] = nloc; b.st[1] = nx; }
        const unsigned old = xb_add(&bar[XB_XSUB(b.x)], 1u);
        const unsigned gen = old / nloc;
        if (old + 1u == (gen + 1u) * nloc) {
            __builtin_amdgcn_fence(__ATOMIC_RELEASE, "agent");
            asm volatile("s_waitcnt vmcnt(0)" ::: "memory");
            const unsigned og = xb_add(&bar[XB_TOP], 1u);
            const unsigned tg = og / nx;
            if (og + 1u == (tg + 1u) * nx) xb_add(&bar[XB_TOPGEN], 1u);
            else XB_SPIN(xb_ld(&bar[XB_TOPGEN]) == tg, bar);
            __builtin_amdgcn_fence(__ATOMIC_ACQUIRE, "agent");
            xb_add(&bar[XB_XGEN(b.x)], 1u);
            asm volatile("s_waitcnt vmcnt(0)" ::: "memory");
        } else {
            XB_SPIN(xb_ld(&bar[XB_XGEN(b.x)]) == gen, bar);
            __builtin_amdgcn_fence(__ATOMIC_ACQUIRE, "agent");
            asm volatile("s_waitcnt vmcnt(0)" ::: "memory");
        }
    }
    __syncthreads();
}

using pg8::Unit; using pg8::pack8;
typedef pg8::u32x4 u32x4;

struct NoMeta {};
struct EpiInProj {
    static constexpr bool PERM = true, WIDEB = false; typedef NoMeta Meta;
    __device__ __forceinline__ Meta prefetch(const Unit&, int, int) const { return Meta{}; }
    bf16* cb; bf16* ccx; bf16* Qb; bf16* Kb; bf16* Vb; const float* ropec; const float* ropes; const float* gq; const float* gk;
    __device__ __forceinline__ void operator()(const f32x4 (&acc)[2][2][4][2], const Unit& u, int wr, int wc, int fr, int fq, const NoMeta&) const {
        asm volatile("" : "+v"(fr), "+v"(fq));
        const int pn = __builtin_amdgcn_readfirstlane(u.pn), pm = __builtin_amdgcn_readfirstlane(u.pm); const bool meta = (pm == NTOK / 256);
#define EPI_FENCE() asm volatile("" ::: "memory")
        if (pn < 2) {
            if (!meta) {
#pragma unroll
                for (int ai = 0; ai < 2; ++ai)
#pragma unroll
                    for (int m = 0; m < 4; ++m) { const int R = pm * 256 + ai * 128 + wr * 64 + m * 16 + fr;
#pragma unroll
                        for (int bj = 0; bj < 2; ++bj) *(u32x4*)(cb + (size_t)R * CONVW + 256 * pn + 128 * bj + 32 * wc + 8 * fq) = pack8(acc[ai][bj][m][0], acc[ai][bj][m][1]);
                        if (m & 1) EPI_FENCE(); } }
        } else if (pn < 6) {
#pragma unroll
            for (int ai = 0; ai < 2; ++ai)
#pragma unroll
                for (int m = 0; m < 4; ++m) { const int rl = ai * 128 + wr * 64 + m * 16 + fr, R = pm * 256 + rl; const int b = R >> 13, i = R & (SEQ - 1);
                    const u32x4 w = pack8(acc[ai][0][m][0] * acc[ai][1][m][0], acc[ai][0][m][1] * acc[ai][1][m][1]);
                    const int col = 128 * (pn - 2) + 32 * wc + 8 * fq;
                    if (!meta) *(u32x4*)(ccx + ((size_t)(b * CCXROWS + 2 + i)) * CONVW + col) = w;
                    else if (rl == 14 || rl == 15) {
#pragma unroll
                        for (int bb = 0; bb < BATCH; ++bb) *(u32x4*)(ccx + ((size_t)(bb * CCXROWS + rl - 14)) * CONVW + col) = w; }
                    if (m & 1) EPI_FENCE(); }
        } else if (pn < 10) {
            const bool isq = pn < 8; const float* g = isq ? gq : gk;
            const int hm = 4 * ((pn - 6) & 1) + wc, head = hm >> 1, mp = hm & 1;
            f32x4 gv[2][2];
#pragma unroll
            for (int bj = 0; bj < 2; ++bj)
#pragma unroll
                for (int n = 0; n < 2; ++n) gv[bj][n] = *(const f32x4*)(g + qk_delta(4 * bj + fq, 4 * n));
#pragma unroll
            for (int ai = 0; ai < 2; ++ai) {
                f32x4 rc[4], rn[4];
#pragma unroll
                for (int m = 0; m < 4; ++m) { const int rl = ai * 128 + wr * 64 + m * 16 + fr, R = pm * 256 + rl, i = R & (SEQ - 1), pos = meta ? (rl & 15) : NMETA + i;
                    rc[m] = *(const f32x4*)(ropec + pos * 8 + 4 * (fq & 1)); rn[m] = *(const f32x4*)(ropes + pos * 8 + 4 * (fq & 1)); }
                EPI_FENCE();
#pragma unroll
                for (int m = 0; m < 4; ++m) {
                    const int rl = ai * 128 + wr * 64 + m * 16 + fr, R = pm * 256 + rl; const int b = R >> 13, i = R & (SEQ - 1);
                    f32x4 y[2][2]; float ss = 0.f;
#pragma unroll
                    for (int bj = 0; bj < 2; ++bj)
#pragma unroll
                        for (int n = 0; n < 2; ++n) { y[bj][n] = acc[ai][bj][m][n]; const f32x4 q = y[bj][n] * y[bj][n]; ss += (q[0] + q[1]) + (q[2] + q[3]); }
                    ss += __shfl_xor(ss, 16); ss += __shfl_xor(ss, 32);
                    const float r = rsqrtf(ss * (1.0f / 64.0f) + EPS) * (isq ? QSCALE : 1.0f);
#pragma unroll
                    for (int bj = 0; bj < 2; ++bj)
#pragma unroll
                        for (int n = 0; n < 2; ++n) y[bj][n] = y[bj][n] * r * gv[bj][n];
                    {
                        const f32x4 a = y[0][0], bq = y[0][1], ra = a * rc[m] - bq * rn[m], rb = bq * rc[m] + a * rn[m];
                        y[0][0] = fq < 2 ? ra : a; y[0][1] = fq < 2 ? rb : bq;
                    }
#pragma unroll
                    for (int bj = 0; bj < 2; ++bj) { const u32x4 w = pack8(y[bj][0], y[bj][1]);
                        if (isq) { if (!meta) *(u32x4*)(Qb + q_off(b, head, mp, i, 4 * bj + fq)) = w; }
                        else if (!meta) *(u32x4*)(Kb + k_off(b, head, (i >> 6) + 1, mp, 4 * bj + fq, i & 63)) = w;
                        else if (rl < NMETA) {
#pragma unroll
                            for (int bb = 0; bb < BATCH; ++bb) *(u32x4*)(Kb + k_off(bb, head, 0, mp, 4 * bj + fq, 48 + rl)) = w; } }
                }
                EPI_FENCE();
            }
        } else {
#pragma unroll
            for (int ai = 0; ai < 2; ++ai)
#pragma unroll
                for (int m = 0; m < 4; ++m) { const int rl = ai * 128 + wr * 64 + m * 16 + fr, R = pm * 256 + rl; const int b = R >> 13, i = R & (SEQ - 1);
#pragma unroll
                    for (int bj = 0; bj < 2; ++bj) { const int head = 2 * (pn - 10) + bj; const u32x4 w = pack8(acc[ai][bj][m][0], acc[ai][bj][m][1]);
                        if (!meta) *(u32x4*)(Vb + v_off(b, head, (i >> 6) + 1, wc, i & 63, 8 * fq)) = w;
                        else if (rl < NMETA) {
#pragma unroll
                            for (int bb = 0; bb < BATCH; ++bb) *(u32x4*)(Vb + v_off(bb, head, 0, wc, 48 + rl, 8 * fq)) = w; } }
                    if (m & 1) EPI_FENCE(); }
        }
#undef EPI_FENCE
    }
};

__device__ __forceinline__ f32x4 bf2f4_lo(unsigned a, unsigned b) { return (f32x4){__builtin_bit_cast(float, a << 16), __builtin_bit_cast(float, a & 0xffff0000u), __builtin_bit_cast(float, b << 16), __builtin_bit_cast(float, b & 0xffff0000u)}; }
typedef int i2v __attribute__((ext_vector_type(2)));
__device__ __forceinline__ i2v pack8_f8(const f32x4 a, const f32x4 b) {
    int w0 = 0, w1 = 0; w0 = __builtin_amdgcn_cvt_pk_fp8_f32(a[0], a[1], w0, false); w0 = __builtin_amdgcn_cvt_pk_fp8_f32(a[2], a[3], w0, true);
    w1 = __builtin_amdgcn_cvt_pk_fp8_f32(b[0], b[1], w1, false); w1 = __builtin_amdgcn_cvt_pk_fp8_f32(b[2], b[3], w1, true); return (i2v){w0, w1}; }
struct EpiOutProj {
    static constexpr bool PERM = true, WIDEB = false; typedef NoMeta Meta;
    __device__ __forceinline__ Meta prefetch(const Unit&, int, int) const { return Meta{}; }
    bf16* hb; unsigned char* hq; const float* xrms;
    __device__ __forceinline__ void operator()(const f32x4 (&acc)[2][2][4][2], const Unit& u, int wr, int wc, int fr, int fq, const NoMeta&) const {
        asm volatile("" : "+v"(fr), "+v"(fq));
        u32x4 xv[2][4][2]; float sx[2][4];
        bf16* const base = hb + ((size_t)u.pm * 256 + wr * 64 + fr) * DM + 256 * u.pn + 32 * wc + 8 * fq;
#pragma unroll
        for (int ai = 0; ai < 2; ++ai)
#pragma unroll
            for (int m = 0; m < 4; ++m) { sx[ai][m] = xrms[(size_t)u.pm * 256 + ai * 128 + wr * 64 + m * 16 + fr];
#pragma unroll
                for (int bj = 0; bj < 2; ++bj) xv[ai][m][bj] = *(const u32x4*)(base + (size_t)(ai * 128 + m * 16) * DM + 128 * bj); }
        __builtin_amdgcn_sched_barrier(0); asm volatile("" ::: "memory");
#pragma unroll
        for (int ai = 0; ai < 2; ++ai)
#pragma unroll
            for (int m = 0; m < 4; ++m) {
                const size_t R = (size_t)u.pm * 256 + ai * 128 + wr * 64 + m * 16 + fr;
#pragma unroll
                for (int bj = 0; bj < 2; ++bj) { const u32x4 x4 = xv[ai][m][bj];
                    const f32x4 h0 = bf2f4_lo(x4.x, x4.y) * sx[ai][m] + acc[ai][bj][m][0], h1 = bf2f4_lo(x4.z, x4.w) * sx[ai][m] + acc[ai][bj][m][1];
                    *(u32x4*)(base + (size_t)(ai * 128 + m * 16) * DM + 128 * bj) = pack8(h0, h1);
                    *(i2v*)(hq + R * DM + 256 * u.pn + 128 * bj + 32 * wc + 8 * fq) = pack8_f8(h0 * F8S_H, h1 * F8S_H); }
            }
    }
};

struct MoeTab { const LAS int* blkstart; const LAS int* cnt; };

struct EpiMoe1 {
    static constexpr bool PERM = true, WIDEB = false;
    MoeTab tb; const float* rowrs; unsigned char* hid;
    struct Meta { float rs[8]; };
    __device__ __forceinline__ Meta prefetch(const Unit& u, int wr, int fr) const {
        asm volatile("" : "+v"(fr));
        const int e = u.pn >> 2, rb = u.pm - tb.blkstart[e], cn = tb.cnt[e]; Meta mt;
#pragma unroll
        for (int q = 0; q < 8; ++q) { const int idx = rb * 256 + (q >> 2) * 128 + wr * 64 + (q & 3) * 16 + fr; const float v = rowrs[(size_t)e * CAP + (idx < cn ? idx : cn - 1)];
            mt.rs[q] = idx < cn ? v * (1.0f / (F8S_H * F8S_W)) : 0.f; }
        return mt;
    }
    __device__ __forceinline__ void operator()(const f32x4 (&acc)[2][2][4][2], const Unit& u, int wr, int wc, int fr, int fq, const Meta& mt) const {
        asm volatile("" : "+v"(fr), "+v"(fq));
        const int ct = u.pn & 3;
#pragma unroll
        for (int ai = 0; ai < 2; ++ai)
#pragma unroll
            for (int m = 0; m < 4; ++m) {
                const int rl = ai * 128 + wr * 64 + m * 16 + fr; const float rs = mt.rs[ai * 4 + m];
                if (rs != 0.f) {
                    f32x4 hv[2];
#pragma unroll
                    for (int n = 0; n < 2; ++n) { const f32x4 g = acc[ai][0][m][n] * rs, up = acc[ai][1][m][n] * rs;
#pragma unroll
                        for (int j = 0; j < 4; ++j) hv[n][j] = g[j] * __builtin_amdgcn_rcpf(1.0f + __builtin_amdgcn_exp2f(-1.4426950408889634f * g[j])) * (up[j] * F8S_HID); }
                    *(i2v*)(hid + ((size_t)u.pm * 256 + rl) * DFF + 128 * ct + 32 * wc + 8 * fq) = pack8_f8(hv[0], hv[1]);
                }
            }
    }
};

constexpr float Y8_SCALE = 16.0f;
struct EpiMoe2 {
    static constexpr bool PERM = true, WIDEB = true;
    MoeTab tb; const int* rowpair; bf16* ybuf;
    struct Meta { unsigned w[8]; };
    __device__ __forceinline__ Meta prefetch(const Unit& u, int wr, int fr) const {
        asm volatile("" : "+v"(fr));
        const int e = u.pn >> 2, rb = u.pm - tb.blkstart[e], cn = tb.cnt[e]; Meta mt;
#pragma unroll
        for (int q = 0; q < 8; ++q) { const int idx = rb * 256 + (q >> 2) * 128 + wr * 64 + (q & 3) * 16 + fr;
            const unsigned w = (unsigned)rowpair[(size_t)e * CAP + (idx < cn ? idx : cn - 1)]; mt.w[q] = idx < cn ? w : 0u; }
        return mt;
    }
    __device__ __forceinline__ void operator()(const f32x4 (&acc)[2][2][4][2], const Unit& u, int wr, int wc, int fr, int fq, const Meta& mt) const {
        asm volatile("" : "+v"(fr), "+v"(fq));
        const int ct = u.pn & 3;
#pragma unroll
        for (int ai = 0; ai < 2; ++ai)
#pragma unroll
            for (int m = 0; m < 4; ++m) {
                const unsigned w = mt.w[ai * 4 + m]; const int pr = (int)(w & 0xffffu); const float gt = __builtin_bit_cast(float, w & 0xffff0000u);
                if (w != 0u) {
                    const float gs = gt * (Y8_SCALE / (F8S_HID * F8S_W));
                    const i2v lo8 = pack8_f8(acc[ai][0][m][0] * gs, acc[ai][0][m][1] * gs), hi8 = pack8_f8(acc[ai][1][m][0] * gs, acc[ai][1][m][1] * gs);
                    typedef int i4v __attribute__((ext_vector_type(4)));
                    *(i4v*)((unsigned char*)ybuf + (size_t)pr * DM + 256 * ct + 64 * wc + 16 * fq) = (i4v){lo8[0], lo8[1], hi8[0], hi8[1]};
                }
            }
    }
};

template <bool IDENT> struct MoeOrderT {
    int G, c, nunits, K; MoeTab tb; const int* rowpair;
#if defined(EPI_VAR)
    bool skip_epi = false; __device__ __forceinline__ bool probe_skip_epi() const { return skip_epi; }
#endif
    __device__ __forceinline__ bool next(int i, Unit& u) const {
        pg8::StaticOrder so; so.nM = nunits >> 2; so.nN = 4; so.nwg = nunits; so.G = G; so.c = c;
        Unit t; if (!so.next(i, t)) return false;
        int e = 0;
        for (int j = 1; j < NEXP; ++j) e += (tb.blkstart[j] <= t.pm) ? 1 : 0;
        u.pm = __builtin_amdgcn_readfirstlane(t.pm); u.pn = __builtin_amdgcn_readfirstlane(4 * e + t.pn); return true;
    }
    __device__ __forceinline__ unsigned arow_raw(const Unit& u, int r) const {
        if constexpr (IDENT) return (unsigned)(u.pm * 256 + r);
        const int e = u.pn >> 2, idx = (u.pm - tb.blkstart[e]) * 256 + r, cn = tb.cnt[e];
        return (unsigned)rowpair[(size_t)e * CAP + (idx < cn ? idx : cn - 1)];
    }
    __device__ __forceinline__ unsigned arow_fin(unsigned raw) const { return (IDENT ? raw : ((raw & 0xffffu) >> 1)) * (unsigned)K; }
};

constexpr int NWAVES = 8;
constexpr int RING_OFF = 0, RING_BYTES = 131072;
constexpr int LDSCTL_OFF = RING_BYTES, MISC_OFF = LDSCTL_OFF + 320;
constexpr int TAB_OFF = LDSCTL_OFF + 1024;
constexpr int LDS_BYTES = 147456;
struct Frame {
    LAS unsigned char* lds; volatile LAS unsigned* MISC; gu32* ctl;
    int tid, lane, wave, vcu, G;
};
struct Args { const float* in[21]; float* out; unsigned char* ws; int ph_lo, ph_hi; };

__device__ __forceinline__ float wave_sum(float v) {
#pragma unroll
    for (int o = 1; o < 64; o <<= 1) v += __shfl_xor(v, o);
    return v;
}
__device__ __forceinline__ float wave_max(float v) {
#pragma unroll
    for (int o = 1; o < 64; o <<= 1) v = fmaxf(v, __shfl_xor(v, o));
    return v;
}

template <bool NTST, class ColPtr>
__device__ __forceinline__ void p0_transpose_item(const ColPtr& src, int ldw, int K, int N, const float* gain, bf16* WT, LAS unsigned* scr, int item, int lane) {
    const int nblk = N / 64, kb = item / nblk, nb = item % nblk, k0 = 64 * kb, n0 = 64 * nb;
    const float* colp = src(n0 + lane) + (size_t)k0 * ldw;
    float v[64];
#pragma unroll
    for (int i = 0; i < 64; ++i) v[i] = __builtin_nontemporal_load(colp + (size_t)i * ldw);
    if (gain) {
#pragma unroll
        for (int i = 0; i < 64; ++i) v[i] *= gain[k0 + i]; }
#pragma unroll
    for (int i = 0; i < 32; ++i) scr[lane * 34 + i] = pk2(v[2 * i], v[2 * i + 1]);
    LDS_WAIT(); asm volatile("" ::: "memory");
    const int c = lane & 7;
#pragma unroll
    for (int j = 0; j < 8; ++j) { const int n = (lane >> 3) + 8 * j; const LAS unsigned long long* s = (const LAS unsigned long long*)(scr + n * 34 + 4 * c);
        const unsigned long long lo = s[0], hi = s[1];
        v4u o; o.x = (unsigned)lo; o.y = (unsigned)(lo >> 32); o.z = (unsigned)hi; o.w = (unsigned)(hi >> 32);
        if (NTST) __builtin_nontemporal_store(o, (GAS v4u*)(WT + (size_t)(n0 + n) * K + k0 + 8 * c)); else *(GAS v4u*)(WT + (size_t)(n0 + n) * K + k0 + 8 * c) = o; }
    LDS_WAIT(); asm volatile("" ::: "memory");
}
template <class ColPtr>
__device__ __forceinline__ void p0_transpose_item_f8(const ColPtr& src, int ldw, int K, int N, const float* gain, float scale, unsigned char* WT, LAS unsigned* scr, int item, int lane) {
    const int nblk = N / 64, kb = item / nblk, nb = item % nblk, k0 = 64 * kb, n0 = 64 * nb;
    const float* colp = src(n0 + lane) + (size_t)k0 * ldw;
    float v[64];
#pragma unroll
    for (int i = 0; i < 64; ++i) v[i] = __builtin_nontemporal_load(colp + (size_t)i * ldw);
    if (gain) {
#pragma unroll
        for (int i = 0; i < 64; ++i) v[i] *= gain[k0 + i] * scale; }
    else {
#pragma unroll
        for (int i = 0; i < 64; ++i) v[i] *= scale; }
#pragma unroll
    for (int i = 0; i < 16; ++i) { int w = 0; w = __builtin_amdgcn_cvt_pk_fp8_f32(v[4 * i], v[4 * i + 1], w, false); w = __builtin_amdgcn_cvt_pk_fp8_f32(v[4 * i + 2], v[4 * i + 3], w, true); scr[lane * 18 + i] = (unsigned)w; }
    LDS_WAIT(); asm volatile("" ::: "memory");
    const int c = lane & 3;
#pragma unroll
    for (int j = 0; j < 4; ++j) { const int n = (lane >> 2) + 16 * j; const LAS unsigned long long* s = (const LAS unsigned long long*)(scr + n * 18 + 4 * c);
        const unsigned long long lo = s[0], hi = s[1];
        v4u o; o.x = (unsigned)lo; o.y = (unsigned)(lo >> 32); o.z = (unsigned)hi; o.w = (unsigned)(hi >> 32);
        __builtin_nontemporal_store(o, (GAS v4u*)(WT + (size_t)(n0 + n) * K + k0 + 16 * c)); }
    LDS_WAIT(); asm volatile("" ::: "memory");
}
struct ColIn { const float* w; __device__ __forceinline__ const float* operator()(int n) const { return w + inproj_col(n); } };
struct ColPlain { const float* w; __device__ __forceinline__ const float* operator()(int n) const { return w + n; } };
struct ColGU { const float* wg; long long du; __device__ __forceinline__ const float* operator()(int n) const { const int ct = n >> 8, bj = (n >> 7) & 1, x = n & 127; return wg + (bj ? du : 0ll) + 128 * ct + x; } };

__device__ __forceinline__ double rope_invfreq(int i) {
    const double t[8] = {1.0, 0.19392274474868576, 0.03760603093086393, 0.007292664737217109, 0.001414213562373095, 0.0002742481756762073, 5.318295896944988e-05, 1.031338537721246e-05};
    double r = t[0];
#pragma unroll
    for (int j = 1; j < 8; ++j) r = (i == j) ? t[j] : r;
    return r;
}

__device__ __forceinline__ void p0_prologue(Frame& F, const Args& a, unsigned char* ws) {
    LAS unsigned* scr = (LAS unsigned*)(F.lds + RING_OFF + F.wave * 16384);
    const int gw = F.vcu * NWAVES + F.wave, NGW = F.G * NWAVES, lane = F.lane;
    const float* x = a.in[0]; const float* meta = a.in[1]; const float* g1 = a.in[2]; const float* w_in = a.in[3];
    const float* w_out = a.in[12]; const float* g2 = a.in[13]; const float* w_rg = a.in[14]; const float* w_re = a.in[16];
    bf16* Wt_in = (bf16*)(ws + WS_WIN); bf16* Wt_out = (bf16*)(ws + WS_WOUT);
    constexpr int I_IN = (DM / 64) * (INCOLS / 64), I_OUT = (DM / 64) * (DM / 64);
    for (int it = gw; it < I_IN + I_OUT; it += NGW) {
        if (it < I_IN) p0_transpose_item<false>(ColIn{w_in}, INCOLS, DM, INCOLS, g1, Wt_in, scr, it, lane);
        else p0_transpose_item<false>(ColPlain{w_out}, DM, DM, DM, nullptr, Wt_out, scr, it - I_IN, lane);
    }
    bf16* xb = (bf16*)(ws + WS_XB); float* xrms = (float*)(ws + WS_RSTD1);
    for (int R0 = 4 * gw; R0 < MROWS; R0 += 4 * NGW) {
        if (R0 >= NTOK + NMETA) {
#pragma unroll
            for (int q = 0; q < 4; ++q) { GAS unsigned long long* o8 = (GAS unsigned long long*)(xb + (size_t)(R0 + q) * DM) + lane;
#pragma unroll
                for (int j = 0; j < 4; ++j) o8[64 * j] = 0ull;
                if (lane == 0) xrms[R0 + q] = 1.0f; }
            continue; }
        f32x4 v[4][4];
#pragma unroll
        for (int q = 0; q < 4; ++q) { const int R = R0 + q;
            const float* xrow = R < NTOK ? x + (size_t)R * DM : meta + (size_t)((R - NTOK) & 15) * DM;
            const GAS f32x4* xr = (const GAS f32x4*)xrow + lane;
#pragma unroll
            for (int j = 0; j < 4; ++j) v[q][j] = __builtin_nontemporal_load(xr + 64 * j); }
#pragma unroll
        for (int q = 0; q < 4; ++q) { const int R = R0 + q; const bool pad = R >= NTOK + NMETA;
            float s = 0.f;
#pragma unroll
            for (int j = 0; j < 4; ++j) s += (v[q][j].x * v[q][j].x + v[q][j].y * v[q][j].y) + (v[q][j].z * v[q][j].z + v[q][j].w * v[q][j].w);
            s = wave_sum(s);
            const float ms = s * (1.0f / DM) + EPS, rs = rsqrtf(ms);
            if (lane == 0) xrms[R] = pad ? 1.0f : sqrtf(ms);
            GAS unsigned long long* o8 = (GAS unsigned long long*)(xb + (size_t)R * DM) + lane;
#pragma unroll
            for (int j = 0; j < 4; ++j) o8[64 * j] = pad ? 0ull : ((unsigned long long)pk2(v[q][j].x * rs, v[q][j].y * rs) | ((unsigned long long)pk2(v[q][j].z * rs, v[q][j].w * rs) << 32)); }
    }
    const int gt = F.vcu * (NWAVES * 64) + F.tid, NGT = F.G * NWAVES * 64;
    float* ropec = (float*)(ws + WS_ROPEC); float* ropes = (float*)(ws + WS_ROPES);
    for (int it = gt; it < (SEQ + NMETA) * 8; it += NGT) { const int pos = it >> 3, i = it & 7;
        const double rev = (double)pos * rope_invfreq(i) * 0.15915494309189535; const float fr = (float)(rev - __builtin_rint(rev));
        ropec[it] = __builtin_amdgcn_cosf(fr); ropes[it] = __builtin_amdgcn_sinf(fr); }
    float* wr = (float*)(ws + WS_WR);
    for (int it = gt; it < 64 * 3 * 64 * 4; it += NGT) { const int c = it & 3, ln = (it >> 2) & 63, cbk = it >> 8, cb = cbk % 3, kb = cbk / 3, k = 16 * kb + 4 * (ln >> 4) + c, j = 16 * cb + (ln & 15);
        wr[it] = j < 4 ? g2[k] * w_rg[k * NGRP + j] : (j < 36 ? g2[k] * w_re[k * NEXP + (j - 4)] : 0.f); }
    bf16* Kb = (bf16*)(ws + WS_K); bf16* Vb = (bf16*)(ws + WS_V);
    for (int it = gt; it < BATCH * NHEAD * 16 * 48; it += NGT) { const int bh = it / (16 * 48), r2 = it % (16 * 48), mc = r2 / 48, row = r2 % 48;
        *(GAS v4u*)(Kb + k_off(bh >> 2, bh & 3, 0, mc >> 3, mc & 7, row)) = (v4u){0u, 0u, 0u, 0u}; }
    for (int it = gt; it < BATCH * NHEAD * 4 * 48 * 4; it += NGT) { const int bh = it / (4 * 48 * 4), r2 = it % (4 * 48 * 4), dq = r2 / (48 * 4), r3 = r2 % (48 * 4), row = r3 >> 2, c8 = (r3 & 3) * 8;
        *(GAS v4u*)(Vb + v_off(bh >> 2, bh & 3, 0, dq, row, c8)) = (v4u){0u, 0u, 0u, 0u}; }
}

constexpr int EWC_ITEMS = NEXP * ((DM / 64) * (1024 / 64) + (DFF / 64) * (DM / 64)), EWC_SPLIT = (EWC_ITEMS * 45) / 100, EWC_GU = NEXP * (DM / 64) * (1024 / 64);
__device__ __forceinline__ void expert_weight_copies(Frame& F, const Args& a, unsigned char* ws, int sl, int nsl, int it_lo, int it_hi) {
    LAS unsigned* scr = (LAS unsigned*)(F.lds + RING_OFF + F.wave * 16384);
    const float* g2 = a.in[13]; const float* w_gate = a.in[18]; const float* w_up = a.in[19]; const float* w_down = a.in[20];
    unsigned char* Wgu = ws + WS_WGU; unsigned char* Wd = ws + WS_WD;
    constexpr int I_GU = (DM / 64) * (1024 / 64), I_D = (DFF / 64) * (DM / 64);
    for (int it = it_lo + sl; it < it_hi; it += nsl) {
        int r = it;
        if (r < NEXP * I_GU) { const int e = r / I_GU; p0_transpose_item_f8(ColGU{w_gate + (size_t)e * DM * DFF, (long long)(w_up - w_gate)}, DFF, DM, 1024, g2, F8S_W, Wgu + (size_t)e * 1024 * DM, scr, r % I_GU, F.lane); continue; }
        r -= NEXP * I_GU;
        { const int e = r / I_D; p0_transpose_item_f8(ColPlain{w_down + (size_t)e * DFF * DM}, DM, DFF, DM, nullptr, F8S_W, Wd + (size_t)e * DM * DFF, scr, r % I_D, F.lane); }
    }
}

__device__ __forceinline__ float bf2f(unsigned short v) { return __builtin_bit_cast(float, (unsigned)v << 16); }
__device__ __forceinline__ void conv_pass(Frame& F, const Args& a, unsigned char* ws) {
    const bf16* cb = (const bf16*)(ws + WS_CB); const bf16* ccx = (const bf16*)(ws + WS_CCX); bf16* mix = (bf16*)(ws + WS_MIX); const float* cw = a.in[4];
    const int gt = F.vcu * (NWAVES * 64) + F.tid, NGT = F.G * NWAVES * 64;
    constexpr int NIT = (NTOK / 2) * (CONVW / 8), UNR = 2;
    for (int it0 = gt; it0 < NIT; it0 += UNR * NGT) {
        v4u z[UNR][4], cbv[UNR][2];
#pragma unroll
        for (int u = 0; u < UNR; ++u) { const int it = it0 + u * NGT; if (it < NIT) {
            const int R = (it >> 6) * 2, c0 = (it & 63) * 8, b = R >> 13, i = R & (SEQ - 1);
            const bf16* zp = ccx + ((size_t)(b * CCXROWS + i)) * CONVW + c0;
#pragma unroll
            for (int r = 0; r < 4; ++r) z[u][r] = *(const GAS v4u*)(zp + r * CONVW);
            cbv[u][0] = *(const GAS v4u*)(cb + (size_t)R * CONVW + c0); cbv[u][1] = *(const GAS v4u*)(cb + (size_t)(R + 1) * CONVW + c0); } }
#pragma unroll
        for (int u = 0; u < UNR; ++u) { const int it = it0 + u * NGT; if (it < NIT) {
            const int R = (it >> 6) * 2, c0 = (it & 63) * 8;
            const f32x4 w0a = *(const f32x4*)(cw + c0), w0b = *(const f32x4*)(cw + c0 + 4), w1a = *(const f32x4*)(cw + CONVW + c0), w1b = *(const f32x4*)(cw + CONVW + c0 + 4),
                        w2a = *(const f32x4*)(cw + 2 * CONVW + c0), w2b = *(const f32x4*)(cw + 2 * CONVW + c0 + 4);
#pragma unroll
            for (int rr = 0; rr < 2; ++rr) { float o[8];
#pragma unroll
                for (int j = 0; j < 8; ++j) { const int sh = (j & 1) * 16; const int q = j >> 1;
                    const float a0 = __builtin_bit_cast(float, ((z[u][rr][q] >> sh) & 0xffffu) << 16), a1 = __builtin_bit_cast(float, ((z[u][rr + 1][q] >> sh) & 0xffffu) << 16), a2 = __builtin_bit_cast(float, ((z[u][rr + 2][q] >> sh) & 0xffffu) << 16);
                    const float cbf = __builtin_bit_cast(float, ((cbv[u][rr][q] >> sh) & 0xffffu) << 16);
                    const float x0 = j < 4 ? w0a[j & 3] : w0b[j & 3], x1 = j < 4 ? w1a[j & 3] : w1b[j & 3], x2 = j < 4 ? w2a[j & 3] : w2b[j & 3];
                    o[j] = cbf * (x0 * a0 + x1 * a1 + x2 * a2); }
                v4u w; w.x = pk2(o[0], o[1]); w.y = pk2(o[2], o[3]); w.z = pk2(o[4], o[5]); w.w = pk2(o[6], o[7]);
                *(GAS v4u*)(mix + (size_t)(R + rr) * DM + c0) = w; } } }
    }
}

namespace att {
#ifndef ATT_SG
#define ATT_SG 3
#endif
__device__ __forceinline__ int crow(int r, int hi) { return (r & 3) + 8 * (r >> 2) + 4 * hi; }
typedef short v4i16_t __attribute__((ext_vector_type(4)));
__device__ __forceinline__ s16x4 vtr(const LAS unsigned char* p) { return __builtin_bit_cast(s16x4, __builtin_amdgcn_ds_read_tr16_b64_v4i16((LAS v4i16_t*)p)); }
__device__ __forceinline__ unsigned cvtpk(float lo, float hi) { typedef float f2 __attribute__((ext_vector_type(2))); typedef __bf16 b2 __attribute__((ext_vector_type(2))); f2 v = {lo, hi}; b2 b = __builtin_convertvector(v, b2); return __builtin_bit_cast(unsigned, b); }

struct Par { const bf16* Qb; const bf16* Kb; const bf16* Vb; bf16* mix; const float* subg; float negM, lam; };

__device__ __forceinline__ void dma16(const GAS unsigned char* gbase, unsigned voff, LAS unsigned char* lds_dst) {
    asm volatile("s_mov_b32 m0, %2\n\ts_nop 0\n\tglobal_load_lds_dwordx4 %0, %1" :: "v"(voff), "s"(gbase), "s"((unsigned)(size_t)lds_dst) : "memory");
}
#define ATT_WAITBAR() do { asm volatile("s_waitcnt vmcnt(0) lgkmcnt(0)" ::: "memory"); __builtin_amdgcn_s_barrier(); asm volatile("" ::: "memory"); } while (0)
#define ATT_WAITBAR4() do { if (VAR == 6 || VAR == 7) break; asm volatile("s_waitcnt vmcnt(4)" ::: "memory"); __builtin_amdgcn_s_barrier(); asm volatile("" ::: "memory"); } while (0)

__device__ __forceinline__ void qkt(f32x16& p0, f32x16& p1, const LAS unsigned char* kb, const bf16x8 (&qf)[4]) {
    const f32x16 zero = {0.f, 0.f, 0.f, 0.f, 0.f, 0.f, 0.f, 0.f, 0.f, 0.f, 0.f, 0.f, 0.f, 0.f, 0.f, 0.f};
#pragma unroll
    for (int d0 = 0; d0 < 4; ++d0) {
        const bf16x8 a0 = *(const LAS bf16x8*)(kb + d0 * 2048), a1 = *(const LAS bf16x8*)(kb + d0 * 2048 + 512);
        if (d0 == 0) { p0 = __builtin_amdgcn_mfma_f32_32x32x16_bf16(a0, qf[0], zero, 0, 0, 0); p1 = __builtin_amdgcn_mfma_f32_32x32x16_bf16(a1, qf[0], zero, 0, 0, 0); }
        else { p0 = __builtin_amdgcn_mfma_f32_32x32x16_bf16(a0, qf[d0], p0, 0, 0, 0); p1 = __builtin_amdgcn_mfma_f32_32x32x16_bf16(a1, qf[d0], p1, 0, 0, 0); }
    }
}
__device__ __forceinline__ void band_mask(f32x16& p0, f32x16& p1, int lim, int hi) {
    int lim2 = lim - 4 * hi; asm volatile("" : "+v"(lim2));
#pragma unroll
    for (int r = 0; r < 16; ++r) { const int c = (r & 3) + 8 * (r >> 2); if (c > lim2) p0[r] = -INFINITY; if (c + 32 > lim2) p1[r] = -INFINITY; }
}
template <bool SHIFT> __device__ __forceinline__ void softmax_pack(f32x16& p0, f32x16& p1, float& lsum, bf16x8 (&pw)[4], float negM) {
#pragma unroll
    for (int r = 0; r < 16; ++r) { p0[r] = __builtin_amdgcn_exp2f(SHIFT ? p0[r] + negM : p0[r]); lsum += p0[r]; }
#pragma unroll
    for (int r = 0; r < 16; ++r) { p1[r] = __builtin_amdgcn_exp2f(SHIFT ? p1[r] + negM : p1[r]); lsum += p1[r]; }
    v4u w;
    w.x = cvtpk(p0[0], p0[1]); w.y = cvtpk(p0[2], p0[3]); w.z = cvtpk(p0[4], p0[5]); w.w = cvtpk(p0[6], p0[7]); pw[0] = __builtin_bit_cast(bf16x8, w);
    w.x = cvtpk(p0[8], p0[9]); w.y = cvtpk(p0[10], p0[11]); w.z = cvtpk(p0[12], p0[13]); w.w = cvtpk(p0[14], p0[15]); pw[1] = __builtin_bit_cast(bf16x8, w);
    w.x = cvtpk(p1[0], p1[1]); w.y = cvtpk(p1[2], p1[3]); w.z = cvtpk(p1[4], p1[5]); w.w = cvtpk(p1[6], p1[7]); pw[2] = __builtin_bit_cast(bf16x8, w);
    w.x = cvtpk(p1[8], p1[9]); w.y = cvtpk(p1[10], p1[11]); w.z = cvtpk(p1[12], p1[13]); w.w = cvtpk(p1[14], p1[15]); pw[3] = __builtin_bit_cast(bf16x8, w);
}
__device__ __forceinline__ void pv(f32x16 (&o)[4], const LAS unsigned char* vb, const bf16x8 (&pw)[4]) {
#pragma unroll
    for (int ks = 0; ks < 4; ++ks)
#pragma unroll
        for (int db = 0; db < 4; ++db) {
            const s16x4 lo = vtr(vb + db * 4096 + ks * 1024), hh = vtr(vb + db * 4096 + ks * 1024 + 512);
            const bf16x8 vf = (bf16x8){lo[0], lo[1], lo[2], lo[3], hh[0], hh[1], hh[2], hh[3]};
            o[db] = __builtin_amdgcn_mfma_f32_32x32x16_bf16(pw[ks], vf, o[db], 0, 0, 0);
        }
}

template <bool SHIFT, bool MASK, int VAR>
__device__ __forceinline__ void att_step(f32x16 (&o)[4], const v4u (&pin)[4], v4u (&pout)[4], float& lsum, const LAS unsigned char* kb, const LAS unsigned char* vb, const LAS unsigned char* vbn,
                                         s16x4 (&vl0)[4], s16x4 (&vh0)[4], const bf16x8 (&qf)[4], float negM, int lim, int hi) {
#define SBAR() __builtin_amdgcn_sched_barrier(0)
#define VOFF(m_) ((((m_) & 3) * 4096) + (((m_) >> 2) * 1024))
#define SOFTPAIR(j_) do { float e0, e1; if ((j_) < 8) { e0 = p0[2 * (j_)]; e1 = p0[2 * (j_) + 1]; } else { e0 = p1[2 * (j_) - 16]; e1 = p1[2 * (j_) - 15]; } \
        if (SHIFT) { e0 += negM; e1 += negM; } \
        if (VAR != 1) { e0 = __builtin_amdgcn_exp2f(e0); e1 = __builtin_amdgcn_exp2f(e1); lsum += e0; lsum += e1; pout[(j_) >> 2][(j_) & 3] = cvtpk(e0, e1); } \
        else { pout[(j_) >> 2][(j_) & 3] = __builtin_bit_cast(unsigned, e0) ^ __builtin_bit_cast(unsigned, e1); } } while (0)
    const f32x16 zero = {0.f, 0.f, 0.f, 0.f, 0.f, 0.f, 0.f, 0.f, 0.f, 0.f, 0.f, 0.f, 0.f, 0.f, 0.f, 0.f};
    bf16x8 kf[8];
#pragma unroll
    for (int d0 = 0; d0 < 4; ++d0) { kf[2 * d0] = *(const LAS bf16x8*)(kb + d0 * 2048); kf[2 * d0 + 1] = *(const LAS bf16x8*)(kb + d0 * 2048 + 512); }
    s16x4 vl[16], vh[16];
#pragma unroll
    for (int m = 0; m < 4; ++m) { vl[m] = vl0[m]; vh[m] = vh0[m]; }
#pragma unroll
    for (int m = 4; m < 8; ++m) { vl[m] = vtr(vb + VOFF(m)); vh[m] = vtr(vb + VOFF(m) + 512); }
    SBAR();
#pragma unroll
    for (int m = 0; m < 4; ++m) {
        const bf16x8 vf = (bf16x8){vl[m][0], vl[m][1], vl[m][2], vl[m][3], vh[m][0], vh[m][1], vh[m][2], vh[m][3]};
        if (VAR != 2) o[m & 3] = __builtin_amdgcn_mfma_f32_32x32x16_bf16(__builtin_bit_cast(bf16x8, pin[m >> 2]), vf, o[m & 3], 0, 0, 0); else asm volatile("" :: "v"(vf));
    }
    SBAR();
    f32x16 p0, p1;
    if (MASK) {
        p0 = __builtin_amdgcn_mfma_f32_32x32x16_bf16(kf[0], qf[0], zero, 0, 0, 0); p1 = __builtin_amdgcn_mfma_f32_32x32x16_bf16(kf[1], qf[0], zero, 0, 0, 0);
#pragma unroll
        for (int d0 = 1; d0 < 4; ++d0) { p0 = __builtin_amdgcn_mfma_f32_32x32x16_bf16(kf[2 * d0], qf[d0], p0, 0, 0, 0); p1 = __builtin_amdgcn_mfma_f32_32x32x16_bf16(kf[2 * d0 + 1], qf[d0], p1, 0, 0, 0); }
        band_mask(p0, p1, lim, hi);
        SBAR();
    } else {
        p0 = __builtin_amdgcn_mfma_f32_32x32x16_bf16(kf[0], qf[0], zero, 0, 0, 0);
#pragma unroll
        for (int d0 = 1; d0 < 4; ++d0) p0 = __builtin_amdgcn_mfma_f32_32x32x16_bf16(kf[2 * d0], qf[d0], p0, 0, 0, 0);
        SBAR();
        p1 = __builtin_amdgcn_mfma_f32_32x32x16_bf16(kf[1], qf[0], zero, 0, 0, 0); SOFTPAIR(0); SBAR();
        p1 = __builtin_amdgcn_mfma_f32_32x32x16_bf16(kf[3], qf[1], p1, 0, 0, 0); SOFTPAIR(1); SBAR();
        p1 = __builtin_amdgcn_mfma_f32_32x32x16_bf16(kf[5], qf[2], p1, 0, 0, 0); SOFTPAIR(2); SBAR();
        p1 = __builtin_amdgcn_mfma_f32_32x32x16_bf16(kf[7], qf[3], p1, 0, 0, 0); SOFTPAIR(3); SBAR();
    }
#pragma unroll
    for (int m = 4; m < 16; ++m) {
        if (m + 4 < 16) { if (VAR == 5 || VAR == 7) { vl[m + 4] = vl[m]; vh[m + 4] = vh[m]; } else { vl[m + 4] = vtr(vb + VOFF(m + 4)); vh[m + 4] = vtr(vb + VOFF(m + 4) + 512); } }
        else { vl0[m - 12] = vtr(vbn + VOFF(m - 12)); vh0[m - 12] = vtr(vbn + VOFF(m - 12) + 512); }
        const bf16x8 vf = (bf16x8){vl[m][0], vl[m][1], vl[m][2], vl[m][3], vh[m][0], vh[m][1], vh[m][2], vh[m][3]};
        if (VAR != 2) o[m & 3] = __builtin_amdgcn_mfma_f32_32x32x16_bf16(__builtin_bit_cast(bf16x8, pin[m >> 2]), vf, o[m & 3], 0, 0, 0); else asm volatile("" :: "v"(vf));
        if (MASK) { if (m < 8) { SOFTPAIR(2 * (m - 4)); SOFTPAIR(2 * (m - 4) + 1); } else { SOFTPAIR(m); } }
        else { SOFTPAIR(m); }
        SBAR();
    }
#undef SOFTPAIR
#undef VOFF
#undef SBAR
}

template <bool SHIFT, int VAR> __device__ __forceinline__ void attn_unit(LAS unsigned char* lds, const Par& P, int b, int head, int qb) {
    const int tid = threadIdx.x, lane = tid & 63, wid = __builtin_amdgcn_readfirstlane(tid >> 6), r32 = lane & 31, hi = lane >> 5, rg = wid >> 1, mp = wid & 1;
    const int i0 = qb * 128, iq = i0 + 32 * rg + r32;
    const int ntl = 2 * qb + 3, mylast = 2 * qb + 1 + (rg >= 2 ? 1 : 0);
    const GAS unsigned char* kg = (const GAS unsigned char*)(P.Kb + k_off(b, head, 0, 0, 0, 0)) + wid * 1024;
    const GAS unsigned char* vg = (const GAS unsigned char*)(P.Vb + v_off(b, head, 0, 0, 0, 0)) + wid * 1024;
    const unsigned l16 = (unsigned)lane * 16u;
    LAS unsigned char* ldw = lds + wid * 1024;
#define ATT_DMA(t_, slot_) do { if (VAR == 3 || VAR == 6 || VAR == 7) break; const size_t go_ = (VAR == 4) ? (size_t)0 : (size_t)(t_) * 16384; LAS unsigned char* d_ = ldw + (slot_) * 32768; \
        const GAS unsigned char* k_ = kg + go_; const GAS unsigned char* v_ = vg + go_; \
        dma16(k_, l16, d_); dma16(k_ + 8192, l16, d_ + 8192); dma16(v_, l16, d_ + 16384); dma16(v_ + 8192, l16, d_ + 24576); } while (0)
    ATT_DMA(0, 0); ATT_DMA(1, 1); ATT_DMA(2, 2);
    bf16x8 qf[4];
#pragma unroll
    for (int d0 = 0; d0 < 4; ++d0) qf[d0] = *(const GAS bf16x8*)(P.Qb + q_off(b, head, mp, i0 + 32 * rg, 2 * d0 + hi) + r32 * 8);
    f32x16 o[4]; const float negM = P.negM;
#pragma unroll
    for (int d = 0; d < 4; ++d)
#pragma unroll
        for (int r = 0; r < 16; ++r) o[d][r] = 0.f;
    float lsum = 0.f;
    const int koff = mp * 8192 + hi * 1024 + r32 * 16, voff = 16384 + ((lane >> 4) & 1) * 32 + (lane & 3) * 8 + (4 * hi + ((lane & 15) >> 2)) * 64;
    ATT_WAITBAR();
    bf16x8 pw0[4];
    {
        f32x16 p0, p1; qkt(p0, p1, lds + koff, qf);
#pragma unroll
        for (int r = 0; r < 16; ++r) { p0[r] = -INFINITY; if ((r & 3) + 8 * (r >> 2) < 16 - 4 * hi) p1[r] = -INFINITY; }
        softmax_pack<SHIFT>(p0, p1, lsum, pw0, negM);
    }
    if (wid >= 4) __builtin_amdgcn_s_setprio(1);
    int s_cur = 0, s_nxt = 1, s_nx2 = 2, s_fre = 3;
    v4u pw[4], pq[4];
#pragma unroll
    for (int i = 0; i < 4; ++i) pw[i] = __builtin_bit_cast(v4u, pw0[i]);
#define ATT_ROT4() do { const int x_ = s_cur; s_cur = s_nxt; s_nxt = s_nx2; s_nx2 = s_fre; s_fre = x_; } while (0)
#define ATT_KB (lds + s_nxt * 32768 + koff)
#define ATT_VB (lds + s_cur * 32768 + voff)
#define ATT_VBN (lds + s_nxt * 32768 + voff)
    s16x4 vl0[4], vh0[4];
#pragma unroll
    for (int m = 0; m < 4; ++m) { vl0[m] = vtr(ATT_VB + (m & 3) * 4096); vh0[m] = vtr(ATT_VB + (m & 3) * 4096 + 512); }
    int t = 0;
    for (; t < 2 * qb; t += 2) {
        att_step<SHIFT, false, VAR>(o, pw, pq, lsum, ATT_KB, ATT_VB, ATT_VBN, vl0, vh0, qf, negM, 0, hi); ATT_DMA(t + 3, s_fre); ATT_WAITBAR4(); ATT_ROT4();
        att_step<SHIFT, false, VAR>(o, pq, pw, lsum, ATT_KB, ATT_VB, ATT_VBN, vl0, vh0, qf, negM, 0, hi); ATT_DMA(t + 4, s_fre); ATT_WAITBAR4(); ATT_ROT4();
    }
    att_step<SHIFT, true, VAR>(o, pw, pq, lsum, ATT_KB, ATT_VB, ATT_VBN, vl0, vh0, qf, negM, iq - 64 * t, hi); ATT_WAITBAR(); ATT_ROT4(); ++t;
    att_step<SHIFT, true, VAR>(o, pq, pw, lsum, ATT_KB, ATT_VB, ATT_VBN, vl0, vh0, qf, negM, iq - 64 * t, hi); ATT_WAITBAR(); ATT_ROT4(); ++t;
    { bf16x8 pl[4];
#pragma unroll
      for (int i = 0; i < 4; ++i) pl[i] = __builtin_bit_cast(bf16x8, pw[i]);
      pv(o, ATT_VB, pl); }
    ATT_WAITBAR();
#undef ATT_ROT4
#undef ATT_KB
#undef ATT_VB
#undef ATT_VBN
#undef ATT_DMA
    __builtin_amdgcn_s_setprio(0);
    { auto rr = __builtin_amdgcn_permlane32_swap(__float_as_uint(lsum), __float_as_uint(lsum), false, false); lsum = __uint_as_float(rr[0]) + __uint_as_float(rr[1]); }
    int le = lane; asm volatile("" : "+v"(le));
    const int r32e = le & 31, hie = le >> 5;
    LAS float* lsc = (LAS float*)(lds + 135168) + wid * 32;
    LAS float* comb = (LAS float*)lds + rg * 4096 + (4 * hie) * 128 + r32e;
    if (hie == 0) lsc[r32e] = lsum;
    LDS_WAIT(); asm volatile("" ::: "memory");
    const float sc = mp ? P.lam : 1.0f;
#pragma unroll
    for (int r = 0; r < 16; ++r) { const float rl = sc / lsc[4 * hie + (r & 3) + 8 * (r >> 2)];
#pragma unroll
        for (int db = 0; db < 4; ++db) o[db][r] *= rl; }
    if (mp == 1) {
#pragma unroll
        for (int r = 0; r < 16; ++r)
#pragma unroll
            for (int db = 0; db < 4; ++db) comb[((r & 3) + 8 * (r >> 2)) * 128 + 32 * db] = o[db][r];
    }
    __syncthreads();
    if (mp == 0) {
        LAS unsigned short* yst = (LAS unsigned short*)(lds + 65536 + rg * 8192) + (4 * hie) * 128 + r32e;
        float sg[4];
#pragma unroll
        for (int db = 0; db < 4; ++db) sg[db] = P.subg[32 * db + r32e];
        const int x1 = (le ^ 1) << 2, x2 = (le ^ 2) << 2, x4 = (le ^ 4) << 2, x8 = (le ^ 8) << 2, x16 = (le ^ 16) << 2;
#pragma unroll
        for (int r = 0; r < 16; ++r) { float s = 0.f; const int qc = (r & 3) + 8 * (r >> 2);
#pragma unroll
            for (int db = 0; db < 4; ++db) { o[db][r] -= comb[qc * 128 + 32 * db]; s += o[db][r] * o[db][r]; }
            s += __builtin_bit_cast(float, __builtin_amdgcn_ds_bpermute(x1, __builtin_bit_cast(int, s))); s += __builtin_bit_cast(float, __builtin_amdgcn_ds_bpermute(x2, __builtin_bit_cast(int, s)));
            s += __builtin_bit_cast(float, __builtin_amdgcn_ds_bpermute(x4, __builtin_bit_cast(int, s))); s += __builtin_bit_cast(float, __builtin_amdgcn_ds_bpermute(x8, __builtin_bit_cast(int, s)));
            s += __builtin_bit_cast(float, __builtin_amdgcn_ds_bpermute(x16, __builtin_bit_cast(int, s)));
            s = rsqrtf(s * (1.0f / 128.0f) + EPS) * 0.8f;
#pragma unroll
            for (int db = 0; db < 4; ++db) yst[qc * 128 + 32 * db] = (unsigned short)f2bf(o[db][r] * s * sg[db]); }
        LDS_WAIT(); asm volatile("" ::: "memory");
        bf16* orow = P.mix + ((size_t)(b * SEQ + i0 + 32 * rg)) * DM + 512 + head * 128;
        const LAS unsigned short* ysr = (const LAS unsigned short*)(lds + 65536 + rg * 8192);
#pragma unroll
        for (int j = 0; j < 8; ++j) { const int q = 4 * j + (le >> 4), ch = le & 15;
            const v4u v = *(const LAS v4u*)(ysr + q * 128 + ch * 8);
            *(GAS v4u*)(orow + (size_t)q * DM + ch * 8) = v; }
    }
    __syncthreads();
}

__device__ __forceinline__ void attn_phase(Frame& F, const Args& a, unsigned char* ws) {
    const float* gq = a.in[5]; const float* gk = a.in[6];
    const float d1 = wave_sum(a.in[7][F.lane] * a.in[8][F.lane]), d2 = wave_sum(a.in[9][F.lane] * a.in[10][F.lane]);
    const float lam = __expf(d1) - __expf(d2) + 0.2f;
    const float mq = wave_max(fabsf(gq[F.lane])), mk = wave_max(fabsf(gk[F.lane]));
    Par P; P.Qb = (const bf16*)(ws + WS_Q); P.Kb = (const bf16*)(ws + WS_K); P.Vb = (const bf16*)(ws + WS_V); P.mix = (bf16*)(ws + WS_MIX); P.subg = a.in[11];
#if defined(ATT_VAR)
    if (a.ph_hi - a.ph_lo == 1) P.mix = (bf16*)(ws + WS_END);
#endif
    P.negM = -(8.0f * mq * mk * 1.4426950408889634f); P.lam = lam;
    const int nun = (F.G == 256) ? 4 : (1024 - F.vcu + F.G - 1) / F.G;
    for (int k = 0; k < nun; ++k) {
        int bh, qb;
        if (F.G == 256) { const int s_ = F.vcu & 15; bh = F.vcu >> 4; qb = (k == 0) ? s_ : (k == 1) ? 31 - s_ : (k == 2) ? 32 + s_ : 63 - s_; }
        else { const int uix = F.vcu + k * F.G; bh = uix >> 6; qb = uix & 63; }
#if defined(ATT_VAR)
        if (a.ph_hi - a.ph_lo == 1) { attn_unit<false, ATT_VAR>(F.lds, P, bh >> 2, bh & 3, qb); continue; }
#endif
        if (P.negM >= -100.0f) attn_unit<false, 0>(F.lds, P, bh >> 2, bh & 3, qb); else attn_unit<true, 0>(F.lds, P, bh >> 2, bh & 3, qb);
    }
}
}

typedef float f32x4v __attribute__((ext_vector_type(4)));
__device__ __forceinline__ void router_phase(Frame& F, const Args& a, unsigned char* ws) {
    const bf16* hb = (const bf16*)(ws + WS_XB); const f32x4* wrB = (const f32x4*)(ws + WS_WR); float* rstd2 = (float*)(ws + WS_RSTD2);
    const float* b_rg = a.in[15]; const float* b_re = a.in[17];
    int* rowpair = (int*)(ws + WS_ROWPAIR); float* rowrs = (float*)(ws + WS_ROWRS); unsigned* cnt = (unsigned*)(F.ctl + CW_CNT);
    LAS float* lgt = (LAS float*)(F.lds + 0);
    LAS int* pe = (LAS int*)(F.lds + 32768);
    LAS float* pg = (LAS float*)(F.lds + 32768 + 1024);
    LAS int* prk = (LAS int*)(F.lds + 32768 + 2048);
    LAS int* hist = (LAS int*)(F.lds + 32768 + 3072);
    const int lane = F.lane, w = F.wave;
    for (int blk = F.vcu; blk < NTOK / 128; blk += F.G) {
        if (F.tid < 64) hist[F.tid] = 0;
        if (w >= 4 && blk == F.vcu) expert_weight_copies(F, a, ws, F.vcu * 4 + (w - 4), F.G * 4, EWC_SPLIT, EWC_GU);
        if (w < 4) {
            const int tok0 = blk * 128 + 32 * w;
            typedef unsigned v2u __attribute__((ext_vector_type(2)));
            const GAS v2u* ap0 = (const GAS v2u*)(hb + (size_t)(tok0 + (lane & 15)) * DM) + (lane >> 4);
            const GAS v2u* ap1 = ap0 + 16 * (DM / 4);
            const GAS f32x4* bp = (const GAS f32x4*)wrB + lane;
            f32x4 acc[2][3]; float sq0 = 0.f, sq1 = 0.f;
#pragma unroll
            for (int r = 0; r < 2; ++r)
#pragma unroll
                for (int c = 0; c < 3; ++c) acc[r][c] = (f32x4){0.f, 0.f, 0.f, 0.f};
            v2u A0[4][2], A1[4][2]; f32x4 B0[4][3], B1[4][3];
#define RT_LDA(dst, bt) do { _Pragma("unroll") for (int j_ = 0; j_ < 4; ++j_) { dst[j_][0] = ap0[((bt) * 4 + j_) * 4]; dst[j_][1] = ap1[((bt) * 4 + j_) * 4]; } } while (0)
#define RT_LDB(dst, bt) do { _Pragma("unroll") for (int j_ = 0; j_ < 4; ++j_) _Pragma("unroll") for (int c_ = 0; c_ < 3; ++c_) dst[j_][c_] = bp[(((bt) * 4 + j_) * 3 + c_) * 64]; } while (0)
            RT_LDA(A0, 0); RT_LDB(B0, 0);
#pragma nounroll
            for (int bt = 0; bt < 16; ++bt) {
                const int b1 = bt + 1 < 16 ? bt + 1 : 15;
                RT_LDA(A1, b1); RT_LDB(B1, b1); __builtin_amdgcn_sched_barrier(0);
#pragma unroll
                for (int j = 0; j < 4; ++j) {
                    const v2u r0 = A0[j][0], r1 = A0[j][1];
                    const f32x4 a0 = {__builtin_bit_cast(float, r0.x << 16), __builtin_bit_cast(float, r0.x & 0xffff0000u), __builtin_bit_cast(float, r0.y << 16), __builtin_bit_cast(float, r0.y & 0xffff0000u)};
                    const f32x4 a1 = {__builtin_bit_cast(float, r1.x << 16), __builtin_bit_cast(float, r1.x & 0xffff0000u), __builtin_bit_cast(float, r1.y << 16), __builtin_bit_cast(float, r1.y & 0xffff0000u)};
                    const f32x4 b0 = B0[j][0], b1v = B0[j][1], b2v = B0[j][2];
                    sq0 += (a0[0] * a0[0] + a0[1] * a0[1]) + (a0[2] * a0[2] + a0[3] * a0[3]); sq1 += (a1[0] * a1[0] + a1[1] * a1[1]) + (a1[2] * a1[2] + a1[3] * a1[3]);
#pragma unroll
                    for (int c = 0; c < 4; ++c) {
                        acc[0][0] = __builtin_amdgcn_mfma_f32_16x16x4f32(a0[c], b0[c], acc[0][0], 0, 0, 0); acc[1][0] = __builtin_amdgcn_mfma_f32_16x16x4f32(a1[c], b0[c], acc[1][0], 0, 0, 0);
                        acc[0][1] = __builtin_amdgcn_mfma_f32_16x16x4f32(a0[c], b1v[c], acc[0][1], 0, 0, 0); acc[1][1] = __builtin_amdgcn_mfma_f32_16x16x4f32(a1[c], b1v[c], acc[1][1], 0, 0, 0);
                        acc[0][2] = __builtin_amdgcn_mfma_f32_16x16x4f32(a0[c], b2v[c], acc[0][2], 0, 0, 0); acc[1][2] = __builtin_amdgcn_mfma_f32_16x16x4f32(a1[c], b2v[c], acc[1][2], 0, 0, 0);
                    }
                }
                __builtin_amdgcn_sched_barrier(0);
#pragma unroll
                for (int j = 0; j < 4; ++j) { A0[j][0] = A1[j][0]; A0[j][1] = A1[j][1];
#pragma unroll
                    for (int c = 0; c < 3; ++c) B0[j][c] = B1[j][c]; }
            }
#undef RT_LDA
#undef RT_LDB
            sq0 += __shfl_xor(sq0, 16); sq0 += __shfl_xor(sq0, 32); sq1 += __shfl_xor(sq1, 16); sq1 += __shfl_xor(sq1, 32);
#pragma unroll
            for (int r = 0; r < 2; ++r)
#pragma unroll
                for (int c = 0; c < 3; ++c)
#pragma unroll
                    for (int q = 0; q < 4; ++q) lgt[(32 * w + 16 * r + 4 * (lane >> 4) + q) * 49 + 16 * c + (lane & 15)] = acc[r][c][q];
            if (lane < 16) { lgt[(32 * w + lane) * 49 + 48] = rsqrtf(sq0 * (1.0f / DM) + EPS); lgt[(32 * w + 16 + lane) * 49 + 48] = rsqrtf(sq1 * (1.0f / DM) + EPS); }
            LDS_WAIT(); asm volatile("" ::: "memory");
            if (lane < 32) {
                const int tl = 32 * w + lane; const LAS float* lg = lgt + tl * 49; const float rs = lg[48];
                rstd2[blk * 128 + tl] = rs;
                int gi = 0; float gl[4]; float gm; const f32x4 brg = *(const f32x4*)b_rg;
#pragma unroll
                for (int j = 0; j < 4; ++j) gl[j] = lg[j] * rs + brg[j];
                gm = gl[0];
#pragma unroll
                for (int j = 1; j < 4; ++j) if (gl[j] > gm) { gm = gl[j]; gi = j; }
                float gs = 0.f;
#pragma unroll
                for (int j = 0; j < 4; ++j) gs += __expf(gl[j] - gm);
                const float gval = 1.0f / gs;
                int e1 = 0, e2 = 0; float m1 = -INFINITY, m2 = -INFINITY;
                const f32x4 bre0 = *(const f32x4*)(b_re + gi * 8), bre1 = *(const f32x4*)(b_re + gi * 8 + 4);
#pragma unroll
                for (int j = 0; j < 8; ++j) { const float x = lg[4 + gi * 8 + j] * rs + (j < 4 ? bre0[j & 3] : bre1[j & 3]);
                    if (x > m1) { m2 = m1; e2 = e1; m1 = x; e1 = j; } else if (x > m2) { m2 = x; e2 = j; } }
                const float r = __expf(m2 - m1), g1v = gval / (1.0f + r), g2v = gval * r / (1.0f + r);
                pe[2 * tl] = gi * 8 + e1; pg[2 * tl] = g1v; pe[2 * tl + 1] = gi * 8 + e2; pg[2 * tl + 1] = g2v;
            }
        }
        __syncthreads();
        if (F.tid < 256) prk[F.tid] = atomicAdd((int*)&hist[pe[F.tid]], 1);
        __syncthreads();
        if (F.tid < 32) hist[32 + F.tid] = (int)__hip_atomic_fetch_add(cnt + 16 * F.tid, (unsigned)hist[F.tid], __ATOMIC_RELAXED, __HIP_MEMORY_SCOPE_AGENT);
        __syncthreads();
        if (F.tid < 256) { const int e = pe[F.tid], pos = hist[32 + e] + prk[F.tid];
            rowpair[(size_t)e * CAP + pos] = (int)((unsigned)(2 * (blk * 128 + (F.tid >> 1)) + (F.tid & 1)) | (f2bf(pg[F.tid]) << 16));
            rowrs[(size_t)e * CAP + pos] = lgt[(F.tid >> 1) * 49 + 48]; }
        __syncthreads();
    }
}

__device__ __forceinline__ MoeTab moe_tables(Frame& F, bool reuse) {
    LAS int* bs = (LAS int*)(F.lds + TAB_OFF); LAS int* cn = (LAS int*)(F.lds + TAB_OFF + 256);
    if (!reuse) {
        __syncthreads();
        if (F.tid < 64) {
            const int c = F.tid < 32 ? (int)__hip_atomic_load(F.ctl + CW_CNT + 16 * (F.tid & 31), RLX_AGENT) : 0; const int nb = (c + 255) >> 8; int s = nb;
#pragma unroll
            for (int o = 1; o < 32; o <<= 1) { const int v = __shfl_up(s, o); if ((F.tid & 63) >= o) s += v; }
            if (F.tid < 32) { cn[F.tid] = c; bs[F.tid] = s - nb; if (F.tid == 31) bs[NEXP] = s; }
        }
        __syncthreads();
    }
    MoeTab t; t.blkstart = bs; t.cnt = cn; return t;
}

__device__ __forceinline__ void combine_pass(Frame& F, const Args& a, unsigned char* ws) {
    typedef unsigned v2u_t __attribute__((ext_vector_type(2))); typedef float f2_t __attribute__((ext_vector_type(2)));
    float* out = a.out; const unsigned char* y = (const unsigned char*)(ws + WS_Y); const bf16* hb = (const bf16*)(ws + WS_XB);
    int tid_ = F.tid; asm volatile("" : "+v"(tid_));
    const int gt = F.vcu * (NWAVES * 64) + tid_, NGT = F.G * NWAVES * 64;
    constexpr int NIT = NTOK * (DM / 8), UNR = 4; constexpr float inv = 1.0f / Y8_SCALE;
    for (int it0 = gt; it0 < NIT; it0 += UNR * NGT) {
        v2u_t y0[UNR], y1[UNR]; v4u hv[UNR];
#pragma unroll
        for (int u = 0; u < UNR; ++u) { const int it = it0 + u * NGT; if (it < NIT) { const size_t tok = (size_t)(it >> 7); const int c0 = (it & 127) * 8;
            y0[u] = *(const GAS v2u_t*)(y + (2 * tok) * DM + c0); y1[u] = *(const GAS v2u_t*)(y + (2 * tok + 1) * DM + c0); hv[u] = *(const GAS v4u*)(hb + tok * DM + c0); } }
#pragma unroll
        for (int u = 0; u < UNR; ++u) { const int it = it0 + u * NGT; if (it < NIT) { const size_t tok = (size_t)(it >> 7); const int c0 = (it & 127) * 8;
            f32x4 h0, h1;
#pragma unroll
            for (int q = 0; q < 4; ++q) {
                const f2_t a2 = (q & 1) ? __builtin_amdgcn_cvt_pk_f32_fp8((int)y0[u][q >> 1], true) : __builtin_amdgcn_cvt_pk_f32_fp8((int)y0[u][q >> 1], false);
                const f2_t b2 = (q & 1) ? __builtin_amdgcn_cvt_pk_f32_fp8((int)y1[u][q >> 1], true) : __builtin_amdgcn_cvt_pk_f32_fp8((int)y1[u][q >> 1], false);
                const float lo = __builtin_bit_cast(float, hv[u][q] << 16) + (a2[0] + b2[0]) * inv, hi2 = __builtin_bit_cast(float, hv[u][q] & 0xffff0000u) + (a2[1] + b2[1]) * inv;
                if (q < 2) { h0[2 * q] = lo; h0[2 * q + 1] = hi2; } else { h1[2 * (q - 2)] = lo; h1[2 * (q - 2) + 1] = hi2; } }
            GAS f32x4* op = (GAS f32x4*)(out + tok * DM + c0); __builtin_nontemporal_store(h0, op); __builtin_nontemporal_store(h1, op + 1); } }
    }
}

constexpr int N_PHASES = 8;
#ifndef MK_SPLIT
#define MK_SPLIT 0
#endif
__device__ __forceinline__ Args load_args() {
#if defined(__HIP_DEVICE_COMPILE__)
    auto kp = __builtin_amdgcn_kernarg_segment_ptr(); asm volatile("" : "+s"(kp));
    typedef const __attribute__((address_space(4))) Args* CArgsP; const CArgsP ap = (CArgsP)kp; Args a;
#pragma unroll
    for (int i = 0; i < 21; ++i) a.in[i] = ap->in[i];
    a.out = ap->out; a.ws = ap->ws; a.ph_lo = ap->ph_lo; a.ph_hi = ap->ph_hi; return a;
#else
    return Args{};
#endif
}
__global__ void __launch_bounds__(NWAVES * 64, 2) hymba_fwd(Args args) {
    extern __shared__ __attribute__((aligned(16))) unsigned char lds[];
    Frame F;
    F.lds = (LAS unsigned char*)lds;
    F.MISC = (volatile LAS unsigned*)(F.lds + MISC_OFF);
    F.tid = threadIdx.x; F.lane = F.tid & 63; F.wave = __builtin_amdgcn_readfirstlane(F.tid >> 6);
    F.G = gridDim.x; { const int bx = blockIdx.x; F.vcu = (F.G % 8 == 0) ? (bx % 8) * (F.G / 8) + bx / 8 : bx; }
    unsigned char* ws = args.ws;
    F.ctl = (gu32*)(ws + WS_CTL);
    for (int u = F.tid; u < (LDS_BYTES - LDSCTL_OFF) / 4; u += NWAVES * 64) ((LAS unsigned*)(F.lds + LDSCTL_OFF))[u] = 0u;
    __syncthreads();
    const int lo = args.ph_lo, hi = args.ph_hi;
    XcdBarrier bar; bar.bar = (unsigned*)(F.ctl + CW_BAR); bar.x = 0; bar.st = nullptr;
    if (hi - lo > 1) bar = xcd_barrier_post((unsigned*)(F.ctl + CW_BAR), F.MISC + 8);
#ifndef PHASE_MASK
#define PHASE_MASK 0xff
#endif
#define IN(k) (((PHASE_MASK >> (k)) & 1) && lo <= (k) && (k) < hi)
#define SEAM(k) do { if (IN(k) && IN((k) + 1)) xcd_barrier(bar); } while (0)

    if (IN(0)) { const Args a0 = load_args(); p0_prologue(F, a0, ws); SEAM(0); }
#if defined(BAR_PROBE)
    if (hi - lo > 1) for (int i_ = 0; i_ < BAR_PROBE; ++i_) xcd_barrier(bar);
#endif

    if (IN(1)) {
        pg8::Gemm g{(const bf16*)(ws + WS_XB), (const bf16*)(ws + WS_WIN), MROWS, INCOLS, DM}; pg8::StaticOrder S; S.init(MROWS, INCOLS, F.G, (int)blockIdx.x);
#if defined(EPI_VAR)
        S.skip_epi = (EPI_VAR == 1) && (hi - lo == 1);
#endif
        const Args a1 = load_args();
        EpiInProj E{(bf16*)(ws + WS_CB), (bf16*)(ws + WS_CCX), (bf16*)(ws + WS_Q), (bf16*)(ws + WS_K), (bf16*)(ws + WS_V),
                    (const float*)(ws + WS_ROPEC), (const float*)(ws + WS_ROPES), a1.in[5], a1.in[6]};
        pg8::gemm_phase<EpiInProj, pg8::StaticOrder, true, false>(F.lds + RING_OFF, g, S, E);
        { const int nu = MROWS / 256 * (INCOLS / 256), heavy = nu % F.G;
          if ((int)blockIdx.x >= heavy) expert_weight_copies(F, a1, ws, ((int)blockIdx.x - heavy) * NWAVES + F.wave, (F.G - heavy) * NWAVES, 0, EWC_SPLIT); }
        SEAM(1);
    }

    if (IN(2)) {
#if defined(ATT_VAR)
        if (hi - lo != 1)
#endif
        { const Args a2 = load_args(); conv_pass(F, a2, ws); }
        { const Args a2 = load_args(); att::attn_phase(F, a2, ws); } SEAM(2); }

    if (IN(3)) {
        pg8::Gemm g{(const bf16*)(ws + WS_MIX), (const bf16*)(ws + WS_WOUT), NTOK, DM, DM}; pg8::StaticOrder S; S.init(NTOK, DM, F.G, (int)blockIdx.x);
#if defined(EPI_VAR)
        S.skip_epi = (EPI_VAR == 1) && (hi - lo == 1);
#endif
        EpiOutProj E{(bf16*)(ws + WS_XB), ws + WS_HQ, (const float*)(ws + WS_RSTD1)};
        pg8::gemm_phase<EpiOutProj, pg8::StaticOrder, true, false>(F.lds + RING_OFF, g, S, E);
        SEAM(3);
    }

    if (IN(4)) { const Args a4 = load_args(); router_phase(F, a4, ws); SEAM(4); }

    if (IN(5)) {
        const MoeTab tb = moe_tables(F, false);
        MoeOrderT<false> S{F.G, (int)blockIdx.x, 4 * tb.blkstart[NEXP], DM  , tb, (const int*)(ws + WS_ROWPAIR)};
#if defined(EPI_VAR)
        S.skip_epi = (EPI_VAR == 1) && (hi - lo == 1);
#endif
        pg8::Gemm g{(const bf16*)(ws + WS_HQ), (const bf16*)(ws + WS_WGU), 0, NEXP * 1024, DM};
        EpiMoe1 E{tb, (const float*)(ws + WS_ROWRS), ws + WS_HID};
        pg8::gemm_phase<EpiMoe1, MoeOrderT<false>, true, true, true>(F.lds + RING_OFF, g, S, E);
        { const int r5 = S.nunits % F.G;
          if ((int)blockIdx.x >= r5) { const Args a5 = load_args(); expert_weight_copies(F, a5, ws, ((int)blockIdx.x - r5) * NWAVES + F.wave, (F.G - r5) * NWAVES, EWC_GU, EWC_ITEMS); } }
        SEAM(5);
    }

    if (IN(6)) {
        const MoeTab tb = moe_tables(F, IN(5));
        MoeOrderT<true> S{F.G, (int)blockIdx.x, 4 * tb.blkstart[NEXP], DFF  , tb, (const int*)(ws + WS_ROWPAIR)};
#if defined(EPI_VAR)
        S.skip_epi = (EPI_VAR == 1) && (hi - lo == 1);
#endif
        pg8::Gemm g{(const bf16*)(ws + WS_HID), (const bf16*)(ws + WS_WD), 0, NEXP * DM, DFF};
        EpiMoe2 E{tb, (const int*)(ws + WS_ROWPAIR), (bf16*)(ws + WS_Y)};
        pg8::gemm_phase<EpiMoe2, MoeOrderT<true>, true, true, true>(F.lds + RING_OFF, g, S, E);
        SEAM(6);
    }

    if (IN(7)) { const Args a7 = load_args(); combine_pass(F, a7, ws); }
#undef IN
#undef SEAM
}

extern "C" void kernel_launch(void* const* d_in, const int* in_sizes, int n_in, void* d_out, int out_size, void* d_ws, size_t ws_size, hipStream_t stream) {
    static int grid = 0;
    if (grid == 0) {
        if (n_in != 21 || in_sizes[0] != NTOK * DM || out_size != NTOK * DM || ws_size < WS_NEED) { fprintf(stderr, "kernel_launch: unexpected shapes (n_in %d, in0 %d, out %d, ws %zu)\n", n_in, n_in > 0 ? in_sizes[0] : -1, out_size, ws_size); grid = -1; return; }
        int dev = 0, cus = 0, per_cu = 0;
        if (hipGetDevice(&dev) != hipSuccess || hipDeviceGetAttribute(&cus, hipDeviceAttributeMultiprocessorCount, dev) != hipSuccess) { grid = -1; return; }
        if (hipFuncSetAttribute((const void*)hymba_fwd, hipFuncAttributeMaxDynamicSharedMemorySize, LDS_BYTES) != hipSuccess) { fprintf(stderr, "kernel_launch: hipFuncSetAttribute failed\n"); grid = -1; return; }
        if (hipOccupancyMaxActiveBlocksPerMultiprocessor(&per_cu, (const void*)hymba_fwd, NWAVES * 64, LDS_BYTES) != hipSuccess || per_cu < 1) { fprintf(stderr, "kernel_launch: occupancy query says %d\n", per_cu); (void)hipGetLastError(); grid = -1; return; }
        grid = cus;
    }
    if (grid < 0) return;
    if (hipMemsetAsync((char*)d_ws + WS_CTL, 0, CTL_ZERO_BYTES, stream) != hipSuccess) return;
    Args a{};
    for (int i = 0; i < 21; ++i) a.in[i] = (const float*)d_in[i];
    a.out = (float*)d_out; a.ws = (unsigned char*)d_ws;
#if defined(REP_MASK)
    { int k = 0; while (!((REP_MASK >> k) & 1)) ++k;
      a.ph_lo = 0; a.ph_hi = k + 1; hipLaunchKernelGGL(hymba_fwd, dim3(grid), dim3(NWAVES * 64), LDS_BYTES, stream, a);
      if (hipMemsetAsync((char*)d_ws + WS_CTL + CW_BAR * 4, 0, XCD_BAR_WORDS * 4, stream) != hipSuccess) return;
      a.ph_lo = k; a.ph_hi = k + 1; hipLaunchKernelGGL(hymba_fwd, dim3(grid), dim3(NWAVES * 64), LDS_BYTES, stream, a);
      if (k + 1 < N_PHASES) { a.ph_lo = k + 1; a.ph_hi = N_PHASES; hipLaunchKernelGGL(hymba_fwd, dim3(grid), dim3(NWAVES * 64), LDS_BYTES, stream, a); } }
#elif MK_SPLIT
    for (int p = 0; p < N_PHASES; ++p) { a.ph_lo = p; a.ph_hi = p + 1; hipLaunchKernelGGL(hymba_fwd, dim3(grid), dim3(NWAVES * 64), LDS_BYTES, stream, a); }
#else
    a.ph_lo = 0; a.ph_hi = N_PHASES;
    hipLaunchKernelGGL(hymba_fwd, dim3(grid), dim3(NWAVES * 64), LDS_BYTES, stream, a);
#endif
}
```

```cpp
#include <hip/hip_runtime.h>
#include <cstdio>
#include <cstdint>
#include <cmath>

#define HD_INL __host__ __device__ __forceinline__
#define GAS __attribute__((address_space(1)))
#define LAS __attribute__((address_space(3)))
typedef unsigned short bf16;
typedef unsigned v4u __attribute__((ext_vector_type(4)));
typedef float f32x4 __attribute__((ext_vector_type(4)));
typedef float f32x16 __attribute__((ext_vector_type(16)));
typedef short bf16x8 __attribute__((ext_vector_type(8)));
typedef short s16x4 __attribute__((ext_vector_type(4)));
typedef GAS unsigned gu32;
#define RLX_AGENT __ATOMIC_RELAXED, __HIP_MEMORY_SCOPE_AGENT
#define LDS_WAIT() asm volatile("s_waitcnt lgkmcnt(0)" ::: "memory")
#define VM_WAIT() asm volatile("s_waitcnt vmcnt(0)" ::: "memory")

constexpr int DM = 1024, BATCH = 4, SEQ = 8192, NMETA = 16;
constexpr int NTOK = BATCH * SEQ;
constexpr int MROWS = NTOK + 256;
constexpr int CONVW = 512, NHEAD = 4, HDIM = 64, VDIM = 128, INCOLS = 3072;
constexpr int NEXP = 32, DFF = 512, NGRP = 4, EPG = 8;
constexpr int KVT = SEQ / 64 + 1;
constexpr int CCXROWS = SEQ + 2;
constexpr int CAP = NTOK;
constexpr float EPS = 1e-6f;
constexpr float QSCALE = 0.125f * 1.4426950408889634f;

constexpr size_t MiB = 1u << 20;
constexpr size_t WS_CTL = 0, CTL_ZERO_BYTES = 128 * 1024;
constexpr size_t WS_RSTD1 = 1 * MiB, WS_RSTD2 = 1 * MiB + 512 * 1024, WS_ROPEC = 2 * MiB, WS_ROPES = 2 * MiB + 512 * 1024, WS_WR = 3 * MiB, WS_MISCF = 3 * MiB + 512 * 1024;
constexpr size_t WS_WIN = 4 * MiB, WS_WOUT = 10 * MiB, WS_WGU = 12 * MiB  , WS_HQ = 44 * MiB  , WS_WD = 76 * MiB  ;
constexpr float F8S_H = 8.0f, F8S_W = 256.0f, F8S_HID = 4.0f;
constexpr size_t WS_ROWPAIR = 108 * MiB, WS_ROWRS = 112 * MiB;
constexpr size_t WS_XB = 116 * MiB;
constexpr size_t WS_MIX = 181 * MiB;
constexpr size_t WS_Y = 342 * MiB;
constexpr size_t WS_CB = 245 * MiB, WS_CCX = 277 * MiB, WS_Q = 310 * MiB;
constexpr size_t WS_HID = 245 * MiB;
constexpr size_t WS_K = 342 * MiB, WS_V = 375 * MiB, WS_END = 408 * MiB  , WS_NEED = 472 * MiB;
static_assert(WS_XB + (size_t)MROWS * DM * 2 <= WS_MIX && WS_Y + (size_t)2 * NTOK * DM * 2 <= WS_NEED && WS_Y >= WS_HID + (size_t)288 * 256 * DFF * 2 && WS_HID + (size_t)288 * 256 * DFF * 2 <= WS_K, "ws map");
static_assert(WS_WGU + (size_t)NEXP * 1024 * DM <= WS_HQ && WS_HQ + (size_t)NTOK * DM <= WS_WD && WS_WD + (size_t)NEXP * DM * DFF <= WS_ROWPAIR, "ws map 3");
static_assert(WS_CCX + (size_t)BATCH * CCXROWS * CONVW * 2 <= WS_Q && WS_K + (size_t)BATCH * NHEAD * KVT * 16384 <= WS_V && WS_V + (size_t)BATCH * NHEAD * KVT * 16384 <= WS_END, "ws map 2");
constexpr int CW_TMO = 0, CW_CODE = 1, CW_ERR = 16  , CW_BAR = 4096, CW_CNT = 16384  , CW_RDY = 20480  ;

HD_INL int qk_delta(int chunk, int e) { const int bj = chunk >> 2, fq = chunk & 3; if (bj == 0 && fq < 2) return e < 4 ? 4 * fq + e : 8 + 4 * fq + (e - 4); return bj == 0 ? 8 * fq + e : 32 + 8 * fq + e; }
HD_INL size_t q_off(int b, int head, int mp, int i, int chunk) { return ((((size_t)(b * 4 + head) * 2 + mp) * 256 + (i >> 5)) * 8 + chunk) * 256 + (size_t)(i & 31) * 8; }
HD_INL size_t k_off(int b, int head, int t, int mp, int chunk, int row) { return (((size_t)(b * 4 + head) * KVT + t) * 2 + mp) * 4096 + (size_t)chunk * 512 + (size_t)row * 8; }
HD_INL size_t v_off(int b, int head, int t, int dq, int row, int dcol) { return ((size_t)(b * 4 + head) * KVT + t) * 8192 + (size_t)dq * 2048 + (size_t)(row >> 4) * 512 + (size_t)(row & 15) * 32 + dcol; }
HD_INL int inproj_col(int n) {
    const int pn = n >> 8, p = n & 255, bj = p >> 7, x = p & 127;
    if (pn < 2 || pn >= 10) return n;
    if (pn < 6) return (bj ? 1024 : 512) + 128 * (pn - 2) + x;
    const int wc = x >> 5, fq = (x >> 3) & 3, e = x & 7;
    return 1536 + 256 * (pn - 6) + 64 * wc + qk_delta(4 * bj + fq, e);
}

namespace pg8 {
#define PG8_LAS __attribute__((address_space(3)))
typedef unsigned short bf16_t;
typedef unsigned u32x4 __attribute__((ext_vector_type(4)));
typedef int i32x4 __attribute__((ext_vector_type(4)));
typedef int i32x8 __attribute__((ext_vector_type(8)));
constexpr int BM = 256, BK = 64, HALF = 128, HTB = HALF * BK * 2  , STAGE_BYTES = 8 * HTB, NXCD = 8, WGM = 8;

__host__ __device__ __forceinline__ int lds_byte(int r, int c) { const int st = (r >> 4) * 2 + (c >> 5), rr = r & 15, cc = c & 31, ob = rr * 64 + cc * 2; return st * 1024 + (ob ^ (((ob >> 9) & 1) << 5)); }
__host__ __device__ __forceinline__ void stage_rc(int b, int& R, int& C) { const int st = b / 1024, sb = b % 1024, swz = sb ^ (((sb >> 9) & 1) << 5); R = (st >> 1) * 16 + swz / 64; C = (st & 1) * 32 + (swz % 64) / 2; }
__host__ __device__ __forceinline__ int perm32(int rho) { const int n = rho >> 4, i = rho & 15; return 8 * (i >> 2) + 4 * n + (i & 3); }

struct Unit { int pm, pn; };
struct Gemm { const bf16_t* A; const bf16_t* Bt; int M, N, K; };

struct StaticOrder {
    int nM, nN, nwg, G, c;
    __host__ __device__ void init(int M, int N, int G_, int c_) { nM = M / BM; nN = N / BM; nwg = nM * nN; G = G_; c = c_; }
    __host__ __device__ bool next(int i, Unit& u) const {
        const long L = (long)i * G + c; if (L >= nwg) return false;
        int wgid = (int)L; { const int q = nwg / NXCD, r = nwg % NXCD, xcd = wgid % NXCD, off = wgid / NXCD; wgid = (xcd < r ? xcd * (q + 1) : r * (q + 1) + (xcd - r) * q) + off; }
        const int nig = WGM * nN, gid = wgid / nig, fm = gid * WGM, gsz = (nM - fm) < WGM ? (nM - fm) : WGM;
        u.pm = fm + ((wgid % nig) % gsz); u.pn = (wgid % nig) / gsz; return true;
    }
    __device__ __forceinline__ unsigned arow_raw(const Unit&, int) const { return 0u; }
    __device__ __forceinline__ unsigned arow_fin(unsigned) const { return 0u; }
#if defined(EPI_VAR)
    bool skip_epi = false; __device__ __forceinline__ bool probe_skip_epi() const { return skip_epi; }
#endif
};

__device__ __forceinline__ unsigned cvt_pk_bf16(float lo, float hi) { unsigned r; asm volatile("v_cvt_pk_bf16_f32 %0, %1, %2" : "=v"(r) : "v"(lo), "v"(hi)); return r; }
__device__ __forceinline__ u32x4 pack8(const f32x4 a, const f32x4 b) { u32x4 w; w.x = cvt_pk_bf16(a[0], a[1]); w.y = cvt_pk_bf16(a[2], a[3]); w.z = cvt_pk_bf16(b[0], b[1]); w.w = cvt_pk_bf16(b[2], b[3]); return w; }

template <class Epi, class Sched, bool ALIGN_EPI, bool GATHER, bool FP8 = false>
__device__ __forceinline__ void gemm_phase(PG8_LAS unsigned char* lds, const Gemm g, const Sched& S, const Epi& E) {
    const int tid = threadIdx.x, wid = __builtin_amdgcn_readfirstlane(tid >> 6), lane = tid & 63, wr = wid >> 2, wc = wid & 3, fr = lane & 15, fq = lane >> 4;
    const int KB = FP8 ? g.K : g.K * 2, nt = KB / (BK * 2);
    unsigned voffA[2], voffB[2];
#pragma unroll
    for (int i = 0; i < 2; ++i) { int R, C; stage_rc(tid * 16 + i * 8192, R, C);
        const int Rb = Epi::WIDEB ? (64 * (R >> 5) + 16 * ((R & 15) >> 2) + 4 * ((R >> 4) & 1) + (R & 3)) : (Epi::PERM ? ((R & ~31) + perm32(R & 31)) : R);
        voffA[i] = (unsigned)(R * KB + C * 2); voffB[i] = (unsigned)(Rb * KB + C * 2); }
    const size_t kstep = (size_t)(BK * 2);
    const size_t hstep = (size_t)HALF * KB;
    const size_t tstep = 2 * hstep;
    const size_t bhs = Epi::WIDEB ? (size_t)8 * KB : hstep;
    const unsigned ldsw = (unsigned)wid * 1024u;
    const int aoff = lds_byte(wr * 64 + fr, fq * 8), boff = lds_byte(wc * 32 + fr, fq * 8);
    unsigned cvo[2][2], nvo[2][2];
#define PG8_SA(b, h) (((b) * 2 + (h)) * HTB)
#define PG8_SB(b, h) ((4 + (b) * 2 + (h)) * HTB)
#define PG8_STAGE(bufoff, gbase, voff) do { _Pragma("unroll") for (int _i = 0; _i < 2; ++_i) \
        __builtin_amdgcn_global_load_lds((const unsigned*)((const char*)(gbase) + (voff)[_i]), (PG8_LAS unsigned*)(lds + (bufoff) + ldsw + _i * 8192), 16, 0, 0); } while (0)
#define PG8_STGA(bufoff, gbase, hh, USE_NEXT) do { if constexpr (GATHER) { _Pragma("unroll") for (int _i = 0; _i < 2; ++_i) { \
        __builtin_amdgcn_global_load_lds((const unsigned*)((const char*)(gbase) + cvo[hh][_i]), (PG8_LAS unsigned*)(lds + (bufoff) + ldsw + _i * 8192), 16, 0, 0); } } \
        else { PG8_STAGE(bufoff, (gbase) + (hh) * hstep, voffA); } } while (0)
#define PG8_LDA(dst, b, h) do { _Pragma("unroll") for (int m = 0; m < 4; ++m) _Pragma("unroll") for (int k = 0; k < 2; ++k) dst[m][k] = *(const PG8_LAS bf16x8*)(lds + PG8_SA(b, h) + aoff + m * 2048 + k * 1024); } while (0)
#define PG8_LDB(dst, b, h) do { _Pragma("unroll") for (int n = 0; n < 2; ++n) _Pragma("unroll") for (int k = 0; k < 2; ++k) dst[n][k] = *(const PG8_LAS bf16x8*)(lds + PG8_SB(b, h) + boff + n * 2048 + k * 1024); } while (0)
#define PG8_SC mxsc
#define PG8_CAT8(x) __builtin_shufflevector(__builtin_bit_cast(i32x4, (x)[0]), __builtin_bit_cast(i32x4, (x)[1]), 0, 1, 2, 3, 4, 5, 6, 7)
#define PG8_MMA(ai, bj, At, Bt) do { __builtin_amdgcn_s_setprio(1); if constexpr (FP8) { _Pragma("unroll") for (int m = 0; m < 4; ++m) _Pragma("unroll") for (int n = 0; n < 2; ++n) \
        acc[ai][bj][m][n] = __builtin_amdgcn_mfma_scale_f32_16x16x128_f8f6f4(PG8_CAT8(Bt[n]), PG8_CAT8(At[m]), acc[ai][bj][m][n], 0, 0, 0, PG8_SC, 0, PG8_SC); } \
      else { _Pragma("unroll") for (int m = 0; m < 4; ++m) _Pragma("unroll") for (int n = 0; n < 2; ++n) _Pragma("unroll") for (int k = 0; k < 2; ++k) \
        acc[ai][bj][m][n] = __builtin_amdgcn_mfma_f32_16x16x32_bf16(Bt[n][k], At[m][k], acc[ai][bj][m][n], 0, 0, 0); } __builtin_amdgcn_s_setprio(0); } while (0)
#define PG8_MMA_THIN(ai, bj, At, Bt) do { if ((ai) == 0 && wr == 0) { __builtin_amdgcn_s_setprio(1); _Pragma("unroll") for (int n = 0; n < 2; ++n) _Pragma("unroll") for (int k = 0; k < 2; ++k) \
        acc[0][bj][0][n] = __builtin_amdgcn_mfma_f32_16x16x32_bf16(Bt[n][k], At[0][k], acc[0][bj][0][n], 0, 0, 0); __builtin_amdgcn_s_setprio(0); } } while (0)
#define PG8_WAIT_V(n) asm volatile("s_waitcnt vmcnt(" #n ")" ::: "memory")
#define PG8_WAIT_L(n) asm volatile("s_waitcnt lgkmcnt(" #n ")" ::: "memory")
#define PG8_BAR __builtin_amdgcn_s_barrier()
#define PG8_SCHED __builtin_amdgcn_sched_barrier(0)
#define PG8_GRAW(dst, un) do { if constexpr (GATHER) { _Pragma("unroll") for (int _i = 0; _i < 2; ++_i) { int R_, C_; stage_rc(tid * 16 + _i * 8192, R_, C_); \
        _Pragma("unroll") for (int _h = 0; _h < 2; ++_h) dst[_h][_i] = S.arow_raw(un, _h * HALF + R_); } } } while (0)
#define PG8_GFIN(dst, src) do { if constexpr (GATHER) { _Pragma("unroll") for (int _i = 0; _i < 2; ++_i) { int R_, C_; stage_rc(tid * 16 + _i * 8192, R_, C_); \
        _Pragma("unroll") for (int _h = 0; _h < 2; ++_h) dst[_h][_i] = S.arow_fin(src[_h][_i]) + (unsigned)C_ * 2u; } } } while (0)
    int mxsc = 0; if constexpr (FP8) asm volatile("s_mov_b32 %0, 0x7f7f7f7f" : "=s"(mxsc));
    Unit cur, nxt; int ui = 0;
    if (!S.next(0, cur)) return;
    f32x4 acc[2][2][4][2];
#pragma unroll
    for (int a = 0; a < 2; ++a)
#pragma unroll
        for (int b = 0; b < 2; ++b)
#pragma unroll
            for (int m = 0; m < 4; ++m)
#pragma unroll
                for (int n = 0; n < 2; ++n) acc[a][b][m][n] = (f32x4){0.f, 0.f, 0.f, 0.f};
    bf16x8 At[4][2], B0[2][2], B1[2][2];
    const char* cA = GATHER ? (const char*)g.A : (const char*)g.A + (size_t)cur.pm * tstep; const char* cB = (const char*)g.Bt + (size_t)cur.pn * tstep;
    PG8_GRAW(nvo, cur); PG8_GFIN(cvo, nvo);
    typename Epi::Meta meta = E.prefetch(cur, wr, fr);
    PG8_STAGE(PG8_SB(0, 0), cB, voffB); PG8_STAGE(PG8_SB(0, 1), cB + bhs, voffB); PG8_STGA(PG8_SA(0, 0), cA, 0, false); PG8_STGA(PG8_SA(0, 1), cA, 1, false);
    if (wr == 1) PG8_BAR;
    PG8_WAIT_V(2); PG8_BAR;
    PG8_STAGE(PG8_SB(1, 0), cB + kstep, voffB); PG8_STGA(PG8_SA(1, 0), cA + kstep, 0, false); PG8_STAGE(PG8_SB(1, 1), cB + bhs + kstep, voffB);
    PG8_WAIT_V(6); PG8_BAR;
    for (;;) {
        const bool has_next = S.next(ui + 1, nxt);
        if constexpr (GATHER) { if (has_next) PG8_GRAW(nvo, nxt); }
        const char* nA = GATHER ? (const char*)g.A : (has_next ? (const char*)g.A + (size_t)nxt.pm * tstep : cA); const char* nB = has_next ? (const char*)g.Bt + (size_t)nxt.pn * tstep : cB;
#define PG8_TRIPS(MMA_) _Pragma("nounroll") for (int t = 0; t < nt; t += 2) { \
            const bool last = (t == nt - 2); \
            const char* a1 = cA + (size_t)(t + 1) * kstep;                                             \
            const char* a2 = last ? nA : cA + (size_t)(t + 2) * kstep; const char* b2 = last ? nB : cB + (size_t)(t + 2) * kstep;     \
            const char* a3 = a2 + kstep; const char* b3 = b2 + kstep;                                \
              \
            PG8_LDB(B0, 0, 0); PG8_LDB(B1, 0, 1); PG8_SCHED; PG8_LDA(At, 0, 0); PG8_STGA(PG8_SA(1, 1), a1, 1, false); \
            if constexpr (GATHER) { if (last && has_next) { asm volatile("" : "+v"(nvo[0][0]), "+v"(nvo[0][1]), "+v"(nvo[1][0]), "+v"(nvo[1][1])); PG8_GFIN(cvo, nvo); } }     \
            PG8_WAIT_V(8); PG8_WAIT_L(0); PG8_BAR; MMA_(0, 0, At, B0); MMA_(0, 1, At, B1); PG8_BAR; PG8_SCHED; \
              \
            PG8_LDA(At, 0, 1); PG8_STAGE(PG8_SB(0, 0), b2, voffB); PG8_STAGE(PG8_SB(0, 1), b2 + bhs, voffB); PG8_STGA(PG8_SA(0, 0), a2, 0, last); \
            PG8_WAIT_V(8); PG8_WAIT_L(0); PG8_BAR; MMA_(1, 0, At, B0); MMA_(1, 1, At, B1); PG8_BAR; PG8_SCHED; \
              \
            PG8_LDB(B0, 1, 0); PG8_LDB(B1, 1, 1); PG8_SCHED; PG8_LDA(At, 1, 0); PG8_STGA(PG8_SA(0, 1), a2, 1, last); \
            PG8_WAIT_V(8); PG8_WAIT_L(0); PG8_BAR; MMA_(0, 0, At, B0); MMA_(0, 1, At, B1); PG8_BAR; PG8_SCHED; \
              \
            PG8_LDA(At, 1, 1); PG8_STAGE(PG8_SB(1, 0), b3, voffB); PG8_STAGE(PG8_SB(1, 1), b3 + bhs, voffB); PG8_STGA(PG8_SA(1, 0), a3, 0, last); \
            PG8_WAIT_V(8); PG8_WAIT_L(0); PG8_BAR; MMA_(1, 0, At, B0); MMA_(1, 1, At, B1); PG8_BAR; PG8_SCHED; \
        }
        if (Epi::THIN && cur.pm == Epi::THIN_PM) { PG8_TRIPS(PG8_MMA_THIN) } else { PG8_TRIPS(PG8_MMA) }
#undef PG8_TRIPS
        if constexpr (ALIGN_EPI) { if (wr == 0) PG8_BAR; }
#if defined(EPI_VAR)
        if (S.probe_skip_epi()) { _Pragma("unroll") for (int a_ = 0; a_ < 2; ++a_) _Pragma("unroll") for (int b_ = 0; b_ < 2; ++b_) _Pragma("unroll") for (int m_ = 0; m_ < 4; ++m_) asm volatile("" :: "v"(acc[a_][b_][m_][0]), "v"(acc[a_][b_][m_][1])); } else
#endif
        E(acc, cur, wr, wc, fr, fq, meta);
        if (!has_next) break;
#pragma unroll
        for (int a = 0; a < 2; ++a)
#pragma unroll
            for (int b = 0; b < 2; ++b)
#pragma unroll
                for (int m = 0; m < 4; ++m)
#pragma unroll
                    for (int n = 0; n < 2; ++n) acc[a][b][m][n] = (f32x4){0.f, 0.f, 0.f, 0.f};
        cur = nxt; cA = nA; cB = nB; ++ui;
        meta = E.prefetch(cur, wr, fr);
        if constexpr (ALIGN_EPI) { if (wr == 1) PG8_BAR; }
    }
    PG8_WAIT_V(0);
    if constexpr (!ALIGN_EPI) { if (wr == 0) PG8_BAR; }
    PG8_BAR;
#undef PG8_SA
#undef PG8_SB
#undef PG8_STAGE
#undef PG8_STGA
#undef PG8_LDA
#undef PG8_LDB
#undef PG8_MMA
#undef PG8_CAT8
#undef PG8_SC
#undef PG8_WAIT_V
#undef PG8_WAIT_L
#undef PG8_BAR
#undef PG8_SCHED
#undef PG8_GRAW
#undef PG8_GFIN
}
}
__device__ __forceinline__ unsigned long long rt() { return __builtin_amdgcn_s_memrealtime(); }
__device__ __forceinline__ unsigned f2bf(float f) { unsigned u = __builtin_bit_cast(unsigned, f); return (u + 0x7fffu + ((u >> 16) & 1u)) >> 16; }
__device__ __forceinline__ unsigned pk2(float lo, float hi) { return f2bf(lo) | (f2bf(hi) << 16); }
#define XB_TMO      128
#define XB_XCNT(j)  (256  + 64 * (j))
#define XB_XSUB(j)  (1280 + 64 * (j))
#define XB_XGEN(j)  (2304 + 64 * (j))
#define XB_TOP      3328
#define XB_TOPGEN   3392
#define XCD_BAR_WORDS 3456
#define XB_SPIN_CAP (1u << 18)

__device__ __forceinline__ unsigned xb_ld(unsigned* p)              { return __hip_atomic_load(p, __ATOMIC_RELAXED, __HIP_MEMORY_SCOPE_AGENT); }
__device__ __forceinline__ unsigned xb_add(unsigned* p, unsigned v) { return __hip_atomic_fetch_add(p, v, __ATOMIC_RELAXED, __HIP_MEMORY_SCOPE_AGENT); }
__device__ __forceinline__ unsigned xb_xcc_id() { return (unsigned)__builtin_amdgcn_s_getreg((3 << 11) | 20) & 0xFu; }
#define XB_SPIN(cond, bar) do { unsigned _sp = 0; while (cond) { __builtin_amdgcn_s_sleep(1); \
    if ((++_sp & 255u) == 0u) { if (xb_ld(&(bar)[XB_TMO])) break; if (_sp > XB_SPIN_CAP) { atomicAdd(&(bar)[XB_TMO], 1u); break; } } } } while (0)

struct XcdBarrier {
    unsigned* bar; unsigned x;
    volatile LAS unsigned* st;
};

__device__ __forceinline__ XcdBarrier xcd_barrier_post(unsigned* bar, volatile LAS unsigned* st) {
    XcdBarrier b; b.bar = bar; b.x = xb_xcc_id(); b.st = st;
    if (threadIdx.x == 0) (void)xb_add(&bar[XB_XCNT(b.x)], 1u);
    return b;
}
__device__ __forceinline__ void xcd_barrier_complete(unsigned* bar, unsigned x, unsigned& nloc, unsigned& nx) {
    const unsigned G = gridDim.x * gridDim.y * gridDim.z;
    unsigned sum, cnt, mine, sp = 0u;
    for (;;) {
        sum = 0u; cnt = 0u; mine = 0u;
#pragma unroll
        for (unsigned j = 0; j < 16; ++j) { const unsigned c = xb_ld(&bar[XB_XCNT(j)]); sum += c; cnt += (c > 0u) ? 1u : 0u; mine = (j == x) ? c : mine; }
        if (sum == G) break;
        __builtin_amdgcn_s_sleep(1);
        if ((++sp & 255u) == 0u) { if (xb_ld(&bar[XB_TMO])) break; if (sp > XB_SPIN_CAP) { atomicAdd(&bar[XB_TMO], 1u); break; } }
    }
    nloc = mine > 0u ? mine : 1u; nx = cnt > 0u ? cnt : 1u;
}

__device__ __forceinline__ void xcd_barrier(const XcdBarrier& b) {
    asm volatile("s_waitcnt vmcnt(0)" ::: "memory");
    __syncthreads();
    if (threadIdx.x == 0) {
        unsigned* bar = b.bar;
        __builtin_amdgcn_s_waitcnt(0);
        unsigned nloc = b.st[0], nx = b.st[1];
        if (nloc == 0u) { xcd_barrier_complete(bar, b.x, nloc, nx); b.st[0] = nloc; b.st[1] = nx; }
        const unsigned old = xb_add(&bar[XB_XSUB(b.x)], 1u);
        const unsigned gen = old / nloc;
        if (old + 1u == (gen + 1u) * nloc) {
            __builtin_amdgcn_fence(__ATOMIC_RELEASE, "agent");
            asm volatile("s_waitcnt vmcnt(0)" ::: "memory");
            const unsigned og = xb_add(&bar[XB_TOP], 1u);
            const unsigned tg = og / nx;
            if (og + 1u == (tg + 1u) * nx) xb_add(&bar[XB_TOPGEN], 1u);
            else XB_SPIN(xb_ld(&bar[XB_TOPGEN]) == tg, bar);
            __builtin_amdgcn_fence(__ATOMIC_ACQUIRE, "agent");
            xb_add(&bar[XB_XGEN(b.x)], 1u);
            asm volatile("s_waitcnt vmcnt(0)" ::: "memory");
        } else {
            XB_SPIN(xb_ld(&bar[XB_XGEN(b.x)]) == gen, bar);
            __builtin_amdgcn_fence(__ATOMIC_ACQUIRE, "agent");
            asm volatile("s_waitcnt vmcnt(0)" ::: "memory");
        }
    }
    __syncthreads();
}

template <class Work> __device__ __forceinline__ void xcd_barrier_work(const XcdBarrier& b, Work&& work) {
    asm volatile("s_waitcnt vmcnt(0)" ::: "memory");
    __syncthreads();
    if (threadIdx.x == 0) {
        unsigned* bar = b.bar;
        __builtin_amdgcn_s_waitcnt(0);
        unsigned nloc = b.st[0], nx = b.st[1];
        if (nloc == 0u) { xcd_barrier_complete(bar, b.x, nloc, nx); b.st[0] = nloc; b.st[1] = nx; }
        const unsigned old = xb_add(&bar[XB_XSUB(b.x)], 1u);
        const unsigned gen = old / nloc;
        if (old + 1u == (gen + 1u) * nloc) {
            __builtin_amdgcn_fence(__ATOMIC_RELEASE, "agent");
            asm volatile("s_waitcnt vmcnt(0)" ::: "memory");
            const unsigned og = xb_add(&bar[XB_TOP], 1u);
            const unsigned tg = og / nx;
            if (og + 1u == (tg + 1u) * nx) xb_add(&bar[XB_TOPGEN], 1u);
            else XB_SPIN(xb_ld(&bar[XB_TOPGEN]) == tg, bar);
            __builtin_amdgcn_fence(__ATOMIC_ACQUIRE, "agent");
            xb_add(&bar[XB_XGEN(b.x)], 1u);
            asm volatile("s_waitcnt vmcnt(0)" ::: "memory");
        } else {
            XB_SPIN(xb_ld(&bar[XB_XGEN(b.x)]) == gen, bar);
            __builtin_amdgcn_fence(__ATOMIC_ACQUIRE, "agent");
            asm volatile("s_waitcnt vmcnt(0)" ::: "memory");
        }
    } else if (threadIdx.x >= 64) work();
    __syncthreads();
}

using pg8::Unit; using pg8::pack8;
typedef pg8::u32x4 u32x4;

struct NoMeta {};
struct EpiInProj {
    static constexpr bool PERM = true, WIDEB = false, THIN = true; static constexpr int THIN_PM = NTOK / 256; typedef NoMeta Meta;
    __device__ __forceinline__ Meta prefetch(const Unit&, int, int) const { return Meta{}; }
    bf16* cb; bf16* ccx; bf16* Qb; bf16* Kb; bf16* Vb; const float* ropec; const float* ropes; const float* gq; const float* gk;
    __device__ __forceinline__ void operator()(const f32x4 (&acc)[2][2][4][2], const Unit& u, int wr, int wc, int fr, int fq, const NoMeta&) const {
        asm volatile("" : "+v"(fr), "+v"(fq));
        const int pn = __builtin_amdgcn_readfirstlane(u.pn), pm = __builtin_amdgcn_readfirstlane(u.pm); const bool meta = (pm == NTOK / 256);
#define EPI_FENCE() asm volatile("" ::: "memory")
        if (pn < 2) {
            if (!meta) {
#pragma unroll
                for (int ai = 0; ai < 2; ++ai)
#pragma unroll
                    for (int m = 0; m < 4; ++m) { const int R = pm * 256 + ai * 128 + wr * 64 + m * 16 + fr;
#pragma unroll
                        for (int bj = 0; bj < 2; ++bj) *(u32x4*)(cb + (size_t)R * CONVW + 256 * pn + 128 * bj + 32 * wc + 8 * fq) = pack8(acc[ai][bj][m][0], acc[ai][bj][m][1]);
                        if (m & 1) EPI_FENCE(); } }
        } else if (pn < 6) {
#pragma unroll
            for (int ai = 0; ai < 2; ++ai)
#pragma unroll
                for (int m = 0; m < 4; ++m) { const int rl = ai * 128 + wr * 64 + m * 16 + fr, R = pm * 256 + rl; const int b = R >> 13, i = R & (SEQ - 1);
                    const u32x4 w = pack8(acc[ai][0][m][0] * acc[ai][1][m][0], acc[ai][0][m][1] * acc[ai][1][m][1]);
                    const int col = 128 * (pn - 2) + 32 * wc + 8 * fq;
                    if (!meta) *(u32x4*)(ccx + ((size_t)(b * CCXROWS + 2 + i)) * CONVW + col) = w;
                    else if (rl == 14 || rl == 15) {
#pragma unroll
                        for (int bb = 0; bb < BATCH; ++bb) *(u32x4*)(ccx + ((size_t)(bb * CCXROWS + rl - 14)) * CONVW + col) = w; }
                    if (m & 1) EPI_FENCE(); }
        } else if (pn < 10) {
            const bool isq = pn < 8; const float* g = isq ? gq : gk;
            const int hm = 4 * ((pn - 6) & 1) + wc, head = hm >> 1, mp = hm & 1;
            f32x4 gv[2][2];
#pragma unroll
            for (int bj = 0; bj < 2; ++bj)
#pragma unroll
                for (int n = 0; n < 2; ++n) gv[bj][n] = *(const f32x4*)(g + qk_delta(4 * bj + fq, 4 * n));
#pragma unroll
            for (int ai = 0; ai < 2; ++ai) {
                f32x4 rc[4], rn[4];
#pragma unroll
                for (int m = 0; m < 4; ++m) { const int rl = ai * 128 + wr * 64 + m * 16 + fr, R = pm * 256 + rl, i = R & (SEQ - 1), pos = meta ? (rl & 15) : NMETA + i;
                    rc[m] = *(const f32x4*)(ropec + pos * 8 + 4 * (fq & 1)); rn[m] = *(const f32x4*)(ropes + pos * 8 + 4 * (fq & 1)); }
                EPI_FENCE();
#pragma unroll
                for (int m = 0; m < 4; ++m) {
                    const int rl = ai * 128 + wr * 64 + m * 16 + fr, R = pm * 256 + rl; const int b = R >> 13, i = R & (SEQ - 1);
                    f32x4 y[2][2]; float ss = 0.f;
#pragma unroll
                    for (int bj = 0; bj < 2; ++bj)
#pragma unroll
                        for (int n = 0; n < 2; ++n) { y[bj][n] = acc[ai][bj][m][n]; const f32x4 q = y[bj][n] * y[bj][n]; ss += (q[0] + q[1]) + (q[2] + q[3]); }
                    { float sa = ss, sb = ss;
                      asm volatile("s_nop 1\n\tv_permlane16_swap_b32 %0, %1" : "+v"(sa), "+v"(sb));
                      ss = sa + sb; sa = ss; sb = ss;
                      asm volatile("s_nop 1\n\tv_permlane32_swap_b32 %0, %1" : "+v"(sa), "+v"(sb));
                      ss = sa + sb; }
                    const float r = rsqrtf(ss * (1.0f / 64.0f) + EPS) * (isq ? QSCALE : 1.0f);
#pragma unroll
                    for (int bj = 0; bj < 2; ++bj)
#pragma unroll
                        for (int n = 0; n < 2; ++n) y[bj][n] = y[bj][n] * r * gv[bj][n];
                    {
                        const f32x4 a = y[0][0], bq = y[0][1], ra = a * rc[m] - bq * rn[m], rb = bq * rc[m] + a * rn[m];
                        y[0][0] = fq < 2 ? ra : a; y[0][1] = fq < 2 ? rb : bq;
                    }
#pragma unroll
                    for (int bj = 0; bj < 2; ++bj) { const u32x4 w = pack8(y[bj][0], y[bj][1]);
                        if (isq) { if (!meta) *(u32x4*)(Qb + q_off(b, head, mp, i, 4 * bj + fq)) = w; }
                        else if (!meta) *(u32x4*)(Kb + k_off(b, head, (i >> 6) + 1, mp, 4 * bj + fq, i & 63)) = w;
                        else if (rl < NMETA) {
#pragma unroll
                            for (int bb = 0; bb < BATCH; ++bb) *(u32x4*)(Kb + k_off(bb, head, 0, mp, 4 * bj + fq, 48 + rl)) = w; } }
                }
                EPI_FENCE();
            }
        } else {
#pragma unroll
            for (int ai = 0; ai < 2; ++ai)
#pragma unroll
                for (int m = 0; m < 4; ++m) { const int rl = ai * 128 + wr * 64 + m * 16 + fr, R = pm * 256 + rl; const int b = R >> 13, i = R & (SEQ - 1);
#pragma unroll
                    for (int bj = 0; bj < 2; ++bj) { const int head = 2 * (pn - 10) + bj; const u32x4 w = pack8(acc[ai][bj][m][0], acc[ai][bj][m][1]);
                        if (!meta) *(u32x4*)(Vb + v_off(b, head, (i >> 6) + 1, wc, i & 63, 8 * fq)) = w;
                        else if (rl < NMETA) {
#pragma unroll
                            for (int bb = 0; bb < BATCH; ++bb) *(u32x4*)(Vb + v_off(bb, head, 0, wc, 48 + rl, 8 * fq)) = w; } }
                    if (m & 1) EPI_FENCE(); }
        }
#undef EPI_FENCE
    }
};

__device__ __forceinline__ f32x4 bf2f4_lo(unsigned a, unsigned b) { return (f32x4){__builtin_bit_cast(float, a << 16), __builtin_bit_cast(float, a & 0xffff0000u), __builtin_bit_cast(float, b << 16), __builtin_bit_cast(float, b & 0xffff0000u)}; }
typedef int i2v __attribute__((ext_vector_type(2)));
__device__ __forceinline__ i2v pack8_f8(const f32x4 a, const f32x4 b) {
    int w0 = 0, w1 = 0; w0 = __builtin_amdgcn_cvt_pk_fp8_f32(a[0], a[1], w0, false); w0 = __builtin_amdgcn_cvt_pk_fp8_f32(a[2], a[3], w0, true);
    w1 = __builtin_amdgcn_cvt_pk_fp8_f32(b[0], b[1], w1, false); w1 = __builtin_amdgcn_cvt_pk_fp8_f32(b[2], b[3], w1, true); return (i2v){w0, w1}; }
struct EpiOutProj {
    static constexpr bool THIN = false; static constexpr int THIN_PM = 0;
    static constexpr bool PERM = true, WIDEB = true; typedef NoMeta Meta;
    __device__ __forceinline__ Meta prefetch(const Unit&, int, int) const { return Meta{}; }
    bf16* hb; unsigned char* hq; const float* xrms;
    __device__ __forceinline__ void operator()(const f32x4 (&acc)[2][2][4][2], const Unit& u, int wr, int wc, int fr, int fq, const NoMeta&) const {
        asm volatile("" : "+v"(fr), "+v"(fq));
        u32x4 xv[2][4][2]; float sx[2][4];
        bf16* const base = hb + ((size_t)u.pm * 256 + wr * 64 + fr) * DM + 256 * u.pn + 64 * wc + 16 * fq;
#pragma unroll
        for (int ai = 0; ai < 2; ++ai)
#pragma unroll
            for (int m = 0; m < 4; ++m) { sx[ai][m] = xrms[(size_t)u.pm * 256 + ai * 128 + wr * 64 + m * 16 + fr];
#pragma unroll
                for (int bj = 0; bj < 2; ++bj) xv[ai][m][bj] = *(const u32x4*)(base + (size_t)(ai * 128 + m * 16) * DM + 8 * bj); }
        __builtin_amdgcn_sched_barrier(0); asm volatile("" ::: "memory");
#pragma unroll
        for (int ai = 0; ai < 2; ++ai)
#pragma unroll
            for (int m = 0; m < 4; ++m) {
                const size_t R = (size_t)u.pm * 256 + ai * 128 + wr * 64 + m * 16 + fr;
                i2v q8[2];
#pragma unroll
                for (int bj = 0; bj < 2; ++bj) { const u32x4 x4 = xv[ai][m][bj];
                    const f32x4 h0 = bf2f4_lo(x4.x, x4.y) * sx[ai][m] + acc[ai][bj][m][0], h1 = bf2f4_lo(x4.z, x4.w) * sx[ai][m] + acc[ai][bj][m][1];
                    *(u32x4*)(base + (size_t)(ai * 128 + m * 16) * DM + 8 * bj) = pack8(h0, h1);
                    q8[bj] = pack8_f8(h0 * F8S_H, h1 * F8S_H); }
                typedef int i4v_ __attribute__((ext_vector_type(4)));
                *(i4v_*)(hq + R * DM + 256 * u.pn + 64 * wc + 16 * fq) = (i4v_){q8[0][0], q8[0][1], q8[1][0], q8[1][1]};
            }
    }
};

struct MoeTab { const LAS int* blkstart; const LAS int* cnt; const LAS unsigned char* b2e; };

struct EpiMoe1 {
    static constexpr bool THIN = false; static constexpr int THIN_PM = 0;
    static constexpr bool PERM = true, WIDEB = false;
    MoeTab tb; const float* rowrs; unsigned char* hid;
    struct Meta { float rs[8]; };
    __device__ __forceinline__ Meta prefetch(const Unit& u, int wr, int fr) const {
        asm volatile("" : "+v"(fr));
        const int e = u.pn >> 2, rb = u.pm - tb.blkstart[e], cn = tb.cnt[e]; Meta mt;
#pragma unroll
        for (int q = 0; q < 8; ++q) { const int idx = rb * 256 + (q >> 2) * 128 + wr * 64 + (q & 3) * 16 + fr; const float v = rowrs[(size_t)e * CAP + (idx < cn ? idx : cn - 1)];
            mt.rs[q] = idx < cn ? v * (1.0f / (F8S_H * F8S_W)) : 0.f; }
        return mt;
    }
    __device__ __forceinline__ void operator()(const f32x4 (&acc)[2][2][4][2], const Unit& u, int wr, int wc, int fr, int fq, const Meta& mt) const {
        asm volatile("" : "+v"(fr), "+v"(fq));
        const int ct = u.pn & 3;
#pragma unroll
        for (int ai = 0; ai < 2; ++ai)
#pragma unroll
            for (int mp = 0; mp < 4; mp += 2) {
                i2v pk[2];
#pragma unroll
                for (int d = 0; d < 2; ++d) { const int m = mp + d; const float rs = mt.rs[ai * 4 + m]; f32x4 hv[2];
#pragma unroll
                    for (int n = 0; n < 2; ++n) { const f32x4 g = acc[ai][0][m][n] * rs, up = acc[ai][1][m][n] * rs;
#pragma unroll
                        for (int j = 0; j < 4; ++j) hv[n][j] = g[j] * __builtin_amdgcn_rcpf(1.0f + __builtin_amdgcn_exp2f(-1.4426950408889634f * g[j])) * (up[j] * F8S_HID); }
                    pk[d] = pack8_f8(hv[0], hv[1]); }
                const auto s0 = __builtin_amdgcn_permlane16_swap((unsigned)pk[0][0], (unsigned)pk[1][0], false, false), s1 = __builtin_amdgcn_permlane16_swap((unsigned)pk[0][1], (unsigned)pk[1][1], false, false);
                const int od = fq & 1, rl = ai * 128 + wr * 64 + (mp + od) * 16 + fr; const float rsel = od ? mt.rs[ai * 4 + mp + 1] : mt.rs[ai * 4 + mp];
                typedef int i4w __attribute__((ext_vector_type(4)));
                if (rsel != 0.f) *(i4w*)(hid + ((size_t)u.pm * 256 + rl) * DFF + 128 * ct + 32 * wc + 16 * (fq >> 1)) = (i4w){(int)s0[0], (int)s1[0], (int)s0[1], (int)s1[1]};
            }
    }
};

constexpr float Y8_SCALE = 16.0f;
struct EpiMoe2 {
    static constexpr bool THIN = false; static constexpr int THIN_PM = 0;
    static constexpr bool PERM = true, WIDEB = true;
    MoeTab tb; const int* rowpair; bf16* ybuf;
    struct Meta { unsigned w[8]; };
    __device__ __forceinline__ Meta prefetch(const Unit& u, int wr, int fr) const {
        asm volatile("" : "+v"(fr));
        const int e = u.pn >> 2, rb = u.pm - tb.blkstart[e], cn = tb.cnt[e]; Meta mt;
#pragma unroll
        for (int q = 0; q < 8; ++q) { const int idx = rb * 256 + (q >> 2) * 128 + wr * 64 + (q & 3) * 16 + fr;
            const unsigned w = (unsigned)rowpair[(size_t)e * CAP + (idx < cn ? idx : cn - 1)]; mt.w[q] = idx < cn ? w : 0u; }
        return mt;
    }
    __device__ __forceinline__ void operator()(const f32x4 (&acc)[2][2][4][2], const Unit& u, int wr, int wc, int fr, int fq, const Meta& mt) const {
        asm volatile("" : "+v"(fr), "+v"(fq));
        const int ct = u.pn & 3;
#pragma unroll
        for (int ai = 0; ai < 2; ++ai)
#pragma unroll
            for (int m = 0; m < 4; ++m) {
                const unsigned w = mt.w[ai * 4 + m]; const int pr = (int)(w & 0xffffu); const float gt = __builtin_bit_cast(float, w & 0xffff0000u);
                if (w != 0u) {
                    const float gs = gt * (Y8_SCALE / (F8S_HID * F8S_W));
                    const i2v lo8 = pack8_f8(acc[ai][0][m][0] * gs, acc[ai][0][m][1] * gs), hi8 = pack8_f8(acc[ai][1][m][0] * gs, acc[ai][1][m][1] * gs);
                    typedef int i4v __attribute__((ext_vector_type(4)));
                    *(i4v*)((unsigned char*)ybuf + (size_t)pr * DM + 256 * ct + 64 * wc + 16 * fq) = (i4v){lo8[0], lo8[1], hi8[0], hi8[1]};
                }
            }
    }
};

template <bool IDENT> struct MoeOrderT {
    int G, c, nunits, K; MoeTab tb; const int* rowpair;
#if defined(EPI_VAR)
    bool skip_epi = false; __device__ __forceinline__ bool probe_skip_epi() const { return skip_epi; }
#endif
    __device__ __forceinline__ bool next(int i, Unit& u) const {
        pg8::StaticOrder so; so.nM = nunits >> 2; so.nN = 4; so.nwg = nunits; so.G = G; so.c = c;
        Unit t; if (!so.next(i, t)) return false;
        const int e = tb.b2e[t.pm];
        u.pm = __builtin_amdgcn_readfirstlane(t.pm); u.pn = __builtin_amdgcn_readfirstlane(4 * e + t.pn); return true;
    }
    __device__ __forceinline__ unsigned arow_raw(const Unit& u, int r) const {
        if constexpr (IDENT) return (unsigned)(u.pm * 256 + r);
        const int e = u.pn >> 2, idx = (u.pm - tb.blkstart[e]) * 256 + r, cn = tb.cnt[e];
        return (unsigned)rowpair[(size_t)e * CAP + (idx < cn ? idx : cn - 1)];
    }
    __device__ __forceinline__ unsigned arow_fin(unsigned raw) const { return (IDENT ? raw : ((raw & 0xffffu) >> 1)) * (unsigned)K; }
};

constexpr int NWAVES = 8;
constexpr int RING_OFF = 0, RING_BYTES = 131072;
constexpr int LDSCTL_OFF = RING_BYTES, MISC_OFF = LDSCTL_OFF + 320;
constexpr int TAB_OFF = LDSCTL_OFF + 1024;
constexpr int LDS_BYTES = 147456;
struct Frame {
    LAS unsigned char* lds; volatile LAS unsigned* MISC; gu32* ctl;
    int tid, lane, wave, vcu, G;
};
struct Args { const float* in[21]; float* out; unsigned char* ws; int ph_lo, ph_hi; };

__device__ __forceinline__ float wave_sum(float v) {
#pragma unroll
    for (int o = 1; o < 64; o <<= 1) v += __shfl_xor(v, o);
    return v;
}
__device__ __forceinline__ float wave_max(float v) {
#pragma unroll
    for (int o = 1; o < 64; o <<= 1) v = fmaxf(v, __shfl_xor(v, o));
    return v;
}

template <bool NTST, class ColPtr>
__device__ __forceinline__ void p0_transpose_item(const ColPtr& src, int ldw, int K, int N, const float* gain, bf16* WT, LAS unsigned* scr, int item, int lane) {
    const int nblk = N / 64, kb = item / nblk, nb = item % nblk, k0 = 64 * kb, n0 = 64 * nb;
    const float* colp = src(n0 + lane) + (size_t)k0 * ldw;
    float v[64];
#pragma unroll
    for (int i = 0; i < 64; ++i) v[i] = __builtin_nontemporal_load(colp + (size_t)i * ldw);
    if (gain) {
#pragma unroll
        for (int i = 0; i < 64; ++i) v[i] *= gain[k0 + i]; }
#pragma unroll
    for (int i = 0; i < 32; ++i) scr[lane * 34 + i] = pk2(v[2 * i], v[2 * i + 1]);
    LDS_WAIT(); asm volatile("" ::: "memory");
    const int c = lane & 7;
#pragma unroll
    for (int j = 0; j < 8; ++j) { const int n = (lane >> 3) + 8 * j; const LAS unsigned long long* s = (const LAS unsigned long long*)(scr + n * 34 + 4 * c);
        const unsigned long long lo = s[0], hi = s[1];
        v4u o; o.x = (unsigned)lo; o.y = (unsigned)(lo >> 32); o.z = (unsigned)hi; o.w = (unsigned)(hi >> 32);
        if (NTST) __builtin_nontemporal_store(o, (GAS v4u*)(WT + (size_t)(n0 + n) * K + k0 + 8 * c)); else *(GAS v4u*)(WT + (size_t)(n0 + n) * K + k0 + 8 * c) = o; }
    LDS_WAIT(); asm volatile("" ::: "memory");
}
template <class ColPtr>
__device__ __forceinline__ void p0_transpose_item_f8(const ColPtr& src, int ldw, int K, int N, const float* gain, float scale, unsigned char* WT, LAS unsigned* scr, int item, int lane) {
    const int nblk = N / 32, kb = item / nblk, nb = item % nblk, k0 = 128 * kb, n0 = 32 * nb, n = lane & 31, kh = lane >> 5;
    const float* colp = src(n0 + n) + (size_t)(k0 + 64 * kh) * ldw;
    float v[64];
#pragma unroll
    for (int i = 0; i < 64; ++i) v[i] = __builtin_nontemporal_load(colp + (size_t)i * ldw);
    if (gain) {
#pragma unroll
        for (int i = 0; i < 64; ++i) { const float ga = gain[k0 + i], gb = gain[k0 + 64 + i]; v[i] *= (kh ? gb : ga) * scale; } }
    else {
#pragma unroll
        for (int i = 0; i < 64; ++i) v[i] *= scale; }
#pragma unroll
    for (int i = 0; i < 16; ++i) { int w = 0; w = __builtin_amdgcn_cvt_pk_fp8_f32(v[4 * i], v[4 * i + 1], w, false); w = __builtin_amdgcn_cvt_pk_fp8_f32(v[4 * i + 2], v[4 * i + 3], w, true); scr[n * 34 + 16 * kh + i] = (unsigned)w; }
    LDS_WAIT(); asm volatile("" ::: "memory");
    const int c = lane & 7;
#pragma unroll
    for (int j = 0; j < 4; ++j) { const int r = (lane >> 3) + 8 * j; const LAS unsigned long long* s = (const LAS unsigned long long*)(scr + r * 34 + 4 * c);
        const unsigned long long lo = s[0], hi = s[1];
        v4u o; o.x = (unsigned)lo; o.y = (unsigned)(lo >> 32); o.z = (unsigned)hi; o.w = (unsigned)(hi >> 32);
        __builtin_nontemporal_store(o, (GAS v4u*)(WT + (size_t)(n0 + r) * K + k0 + 16 * c)); }
    LDS_WAIT(); asm volatile("" ::: "memory");
}
struct ColIn { const float* w; __device__ __forceinline__ const float* operator()(int n) const { return w + inproj_col(n); } };
struct ColPlain { const float* w; __device__ __forceinline__ const float* operator()(int n) const { return w + n; } };
struct ColGU { const float* wg; long long du; __device__ __forceinline__ const float* operator()(int n) const { const int ct = n >> 8, bj = (n >> 7) & 1, x = n & 127; return wg + (bj ? du : 0ll) + 128 * ct + x; } };

__device__ __forceinline__ double rope_invfreq(int i) {
    const double t[8] = {1.0, 0.19392274474868576, 0.03760603093086393, 0.007292664737217109, 0.001414213562373095, 0.0002742481756762073, 5.318295896944988e-05, 1.031338537721246e-05};
    double r = t[0];
#pragma unroll
    for (int j = 1; j < 8; ++j) r = (i == j) ? t[j] : r;
    return r;
}

__device__ __forceinline__ void p0_prologue(Frame& F, const Args& a, unsigned char* ws) {
    LAS unsigned* scr = (LAS unsigned*)(F.lds + RING_OFF + F.wave * 16384);
    const int gw = F.vcu * NWAVES + F.wave, NGW = F.G * NWAVES, lane = F.lane;
    const float* x = a.in[0]; const float* meta = a.in[1]; const float* g1 = a.in[2]; const float* w_in = a.in[3];
    const float* w_out = a.in[12]; const float* g2 = a.in[13]; const float* w_rg = a.in[14]; const float* w_re = a.in[16];
    bf16* Wt_in = (bf16*)(ws + WS_WIN); bf16* Wt_out = (bf16*)(ws + WS_WOUT);
    constexpr int I_IN = (DM / 64) * (INCOLS / 64), I_OUT = (DM / 64) * (DM / 64);
    for (int it = gw; it < I_IN + I_OUT; it += NGW) {
        if (it < I_IN) p0_transpose_item<false>(ColIn{w_in}, INCOLS, DM, INCOLS, g1, Wt_in, scr, it, lane);
        else p0_transpose_item<false>(ColPlain{w_out}, DM, DM, DM, nullptr, Wt_out, scr, it - I_IN, lane);
    }
    bf16* xb = (bf16*)(ws + WS_XB); float* xrms = (float*)(ws + WS_RSTD1);
    for (int R0 = 4 * gw; R0 < MROWS; R0 += 4 * NGW) {
        if (R0 >= NTOK + NMETA) {
#pragma unroll
            for (int q = 0; q < 4; ++q) { GAS unsigned long long* o8 = (GAS unsigned long long*)(xb + (size_t)(R0 + q) * DM) + lane;
#pragma unroll
                for (int j = 0; j < 4; ++j) o8[64 * j] = 0ull;
                if (lane == 0) xrms[R0 + q] = 1.0f; }
            continue; }
        f32x4 v[4][4];
#pragma unroll
        for (int q = 0; q < 4; ++q) { const int R = R0 + q;
            const float* xrow = R < NTOK ? x + (size_t)R * DM : meta + (size_t)((R - NTOK) & 15) * DM;
            const GAS f32x4* xr = (const GAS f32x4*)xrow + lane;
#pragma unroll
            for (int j = 0; j < 4; ++j) v[q][j] = __builtin_nontemporal_load(xr + 64 * j); }
#pragma unroll
        for (int q = 0; q < 4; ++q) { const int R = R0 + q; const bool pad = R >= NTOK + NMETA;
            float s = 0.f;
#pragma unroll
            for (int j = 0; j < 4; ++j) s += (v[q][j].x * v[q][j].x + v[q][j].y * v[q][j].y) + (v[q][j].z * v[q][j].z + v[q][j].w * v[q][j].w);
            s = wave_sum(s);
            const float ms = s * (1.0f / DM) + EPS, rs = rsqrtf(ms);
            if (lane == 0) xrms[R] = pad ? 1.0f : sqrtf(ms);
            GAS unsigned long long* o8 = (GAS unsigned long long*)(xb + (size_t)R * DM) + lane;
#pragma unroll
            for (int j = 0; j < 4; ++j) o8[64 * j] = pad ? 0ull : ((unsigned long long)pk2(v[q][j].x * rs, v[q][j].y * rs) | ((unsigned long long)pk2(v[q][j].z * rs, v[q][j].w * rs) << 32)); }
    }
    const int gt = F.vcu * (NWAVES * 64) + F.tid, NGT = F.G * NWAVES * 64;
    float* ropec = (float*)(ws + WS_ROPEC); float* ropes = (float*)(ws + WS_ROPES);
    for (int it = gt; it < (SEQ + NMETA) * 8; it += NGT) { const int pos = it >> 3, i = it & 7;
        const double rev = (double)pos * rope_invfreq(i) * 0.15915494309189535; const float fr = (float)(rev - __builtin_rint(rev));
        ropec[it] = __builtin_amdgcn_cosf(fr); ropes[it] = __builtin_amdgcn_sinf(fr); }
    unsigned* wr = (unsigned*)(ws + WS_WR);
    for (int it = gt; it < 32 * 3 * 2 * 64 * 4; it += NGT) { const int wd = it & 3, ln = (it >> 2) & 63, f = it >> 8, sp = f & 1, cb = (f >> 1) % 3, ks = (f >> 1) / 3, k = 32 * ks + 8 * (ln >> 4) + 2 * wd, j = 16 * cb + (ln & 15);
        unsigned o = 0u;
#pragma unroll
        for (int e = 0; e < 2; ++e) { const int kk = k + e; const float wv = j < 4 ? g2[kk] * w_rg[kk * NGRP + j] : (j < 36 ? g2[kk] * w_re[kk * NEXP + (j - 4)] : 0.f);
            const unsigned hi = f2bf(wv), lo = f2bf(wv - __builtin_bit_cast(float, hi << 16)); o |= (sp ? lo : hi) << (16 * e); }
        wr[it] = o; }
    bf16* Kb = (bf16*)(ws + WS_K); bf16* Vb = (bf16*)(ws + WS_V);
    for (int it = gt; it < BATCH * NHEAD * 16 * 48; it += NGT) { const int bh = it / (16 * 48), r2 = it % (16 * 48), mc = r2 / 48, row = r2 % 48;
        *(GAS v4u*)(Kb + k_off(bh >> 2, bh & 3, 0, mc >> 3, mc & 7, row)) = (v4u){0u, 0u, 0u, 0u}; }
    for (int it = gt; it < BATCH * NHEAD * 4 * 48 * 4; it += NGT) { const int bh = it / (4 * 48 * 4), r2 = it % (4 * 48 * 4), dq = r2 / (48 * 4), r3 = r2 % (48 * 4), row = r3 >> 2, c8 = (r3 & 3) * 8;
        *(GAS v4u*)(Vb + v_off(bh >> 2, bh & 3, 0, dq, row, c8)) = (v4u){0u, 0u, 0u, 0u}; }
}

constexpr int EWC_ITEMS = NEXP * ((DM / 64) * (1024 / 64) + (DFF / 64) * (DM / 64)), EWC_SPLIT = 5632  , EWC_GU = NEXP * (DM / 64) * (1024 / 64);
__device__ __forceinline__ void expert_weight_copies(Frame& F, const Args& a, unsigned char* ws, int sl, int nsl, int it_lo, int it_hi) {
    LAS unsigned* scr = (LAS unsigned*)(F.lds + RING_OFF + F.wave * 16384);
    const float* g2 = a.in[13]; const float* w_gate = a.in[18]; const float* w_up = a.in[19]; const float* w_down = a.in[20];
    unsigned char* Wgu = ws + WS_WGU; unsigned char* Wd = ws + WS_WD;
    constexpr int I_GU = (DM / 128) * (1024 / 32), I_D = (DFF / 128) * (DM / 32);
    for (int it = it_lo + sl; it < it_hi; it += nsl) {
        int r = it;
        if (r < NEXP * I_GU) { const int e = r / I_GU; p0_transpose_item_f8(ColGU{w_gate + (size_t)e * DM * DFF, (long long)(w_up - w_gate)}, DFF, DM, 1024, g2, F8S_W, Wgu + (size_t)e * 1024 * DM, scr, r % I_GU, F.lane); continue; }
        r -= NEXP * I_GU;
        { const int e = r / I_D; p0_transpose_item_f8(ColPlain{w_down + (size_t)e * DFF * DM}, DM, DFF, DM, nullptr, F8S_W, Wd + (size_t)e * DM * DFF, scr, r % I_D, F.lane); }
    }
}

struct EwcItem { const float* colp; int ldw; const float* gain; unsigned char* wt; int K, k0, n0; };
__device__ __forceinline__ EwcItem ewc_decode(int it, int lane, const float* g2, const float* w_gate, const float* w_up, const float* w_down, unsigned char* Wgu, unsigned char* Wd) {
    constexpr int I_GU = (DM / 128) * (1024 / 32), I_D = (DFF / 128) * (DM / 32);
    const int n = lane & 31, kh = lane >> 5; EwcItem d;
    if (it < NEXP * I_GU) { const int e = it / I_GU, item = it % I_GU, nblk = 1024 / 32, kb = item / nblk, nb = item % nblk; d.k0 = 128 * kb; d.n0 = 32 * nb; d.ldw = DFF; d.K = DM; d.gain = g2; d.wt = Wgu + (size_t)e * 1024 * DM;
        d.colp = ColGU{w_gate + (size_t)e * DM * DFF, (long long)(w_up - w_gate)}(d.n0 + n) + (size_t)(d.k0 + 64 * kh) * DFF; }
    else { const int r = it - NEXP * I_GU, e = r / I_D, item = r % I_D, nblk = DM / 32, kb = item / nblk, nb = item % nblk; d.k0 = 128 * kb; d.n0 = 32 * nb; d.ldw = DM; d.K = DFF; d.gain = nullptr; d.wt = Wd + (size_t)e * DM * DFF;
        d.colp = w_down + (size_t)e * DFF * DM + (d.n0 + n) + (size_t)(d.k0 + 64 * kh) * DM; }
    return d;
}
__device__ __forceinline__ void ewc_load(float (&v)[64], const EwcItem& d) {
#pragma unroll
    for (int i = 0; i < 64; ++i) v[i] = __builtin_nontemporal_load(d.colp + (size_t)i * d.ldw);
}
__device__ __forceinline__ void ewc_finish(float (&v)[64], const EwcItem& d, LAS unsigned* scr, int lane) {
    const int n = lane & 31, kh = lane >> 5;
    if (d.gain) {
#pragma unroll
        for (int i = 0; i < 64; ++i) { const float ga = d.gain[d.k0 + i], gb = d.gain[d.k0 + 64 + i]; v[i] *= (kh ? gb : ga) * F8S_W; } }
    else {
#pragma unroll
        for (int i = 0; i < 64; ++i) v[i] *= F8S_W; }
#pragma unroll
    for (int i = 0; i < 16; ++i) { int w = 0; w = __builtin_amdgcn_cvt_pk_fp8_f32(v[4 * i], v[4 * i + 1], w, false); w = __builtin_amdgcn_cvt_pk_fp8_f32(v[4 * i + 2], v[4 * i + 3], w, true); scr[n * 34 + 16 * kh + i] = (unsigned)w; }
    LDS_WAIT(); asm volatile("" ::: "memory");
    const int c = lane & 7;
#pragma unroll
    for (int j = 0; j < 4; ++j) { const int r = (lane >> 3) + 8 * j; const LAS unsigned long long* sp = (const LAS unsigned long long*)(scr + r * 34 + 4 * c);
        const unsigned long long lo = sp[0], hi = sp[1];
        v4u o; o.x = (unsigned)lo; o.y = (unsigned)(lo >> 32); o.z = (unsigned)hi; o.w = (unsigned)(hi >> 32);
        __builtin_nontemporal_store(o, (GAS v4u*)(d.wt + (size_t)(d.n0 + r) * d.K + d.k0 + 16 * c)); }
    LDS_WAIT(); asm volatile("" ::: "memory");
}
__device__ __forceinline__ void ewc_pair(Frame& F, const Args& a, unsigned char* ws, int itA, int itB, int it_hi) {
    if (itA >= it_hi) return;
    LAS unsigned* scr = (LAS unsigned*)(F.lds + RING_OFF + F.wave * 16384);
    const float* g2 = a.in[13]; const float* w_gate = a.in[18]; const float* w_up = a.in[19]; const float* w_down = a.in[20];
    unsigned char* Wgu = ws + WS_WGU; unsigned char* Wd = ws + WS_WD;
    float vA[64]; const EwcItem dA = ewc_decode(itA, F.lane, g2, w_gate, w_up, w_down, Wgu, Wd); ewc_load(vA, dA);
    if (itB < it_hi) { float vB[64]; const EwcItem dB = ewc_decode(itB, F.lane, g2, w_gate, w_up, w_down, Wgu, Wd); ewc_load(vB, dB);
        ewc_finish(vA, dA, scr, F.lane); ewc_finish(vB, dB, scr, F.lane); }
    else ewc_finish(vA, dA, scr, F.lane);
}

__device__ __forceinline__ float bf2f(unsigned short v) { return __builtin_bit_cast(float, (unsigned)v << 16); }
__device__ __forceinline__ void conv_pass(Frame& F, const Args& a, unsigned char* ws) {
    const bf16* cb = (const bf16*)(ws + WS_CB); const bf16* ccx = (const bf16*)(ws + WS_CCX); bf16* mix = (bf16*)(ws + WS_MIX); const float* cw = a.in[4];
    const int gt = F.vcu * (NWAVES * 64) + F.tid, NGT = F.G * NWAVES * 64;
    constexpr int NIT = (NTOK / 2) * (CONVW / 8), UNR = 2;
    const int c0 = (gt & 63) * 8;
    const f32x4 w0a = *(const f32x4*)(cw + c0), w0b = *(const f32x4*)(cw + c0 + 4), w1a = *(const f32x4*)(cw + CONVW + c0), w1b = *(const f32x4*)(cw + CONVW + c0 + 4),
                w2a = *(const f32x4*)(cw + 2 * CONVW + c0), w2b = *(const f32x4*)(cw + 2 * CONVW + c0 + 4);
    for (int it0 = gt; it0 < NIT; it0 += UNR * NGT) {
        v4u z[UNR][4], cbv[UNR][2];
#pragma unroll
        for (int u = 0; u < UNR; ++u) { const int it = it0 + u * NGT; if (it < NIT) {
            const int R = (it >> 6) * 2, b = R >> 13, i = R & (SEQ - 1);
            const bf16* zp = ccx + ((size_t)(b * CCXROWS + i)) * CONVW + c0;
#pragma unroll
            for (int r = 0; r < 4; ++r) z[u][r] = *(const GAS v4u*)(zp + r * CONVW);
            cbv[u][0] = *(const GAS v4u*)(cb + (size_t)R * CONVW + c0); cbv[u][1] = *(const GAS v4u*)(cb + (size_t)(R + 1) * CONVW + c0); } }
#pragma unroll
        for (int u = 0; u < UNR; ++u) { const int it = it0 + u * NGT; if (it < NIT) {
            const int R = (it >> 6) * 2;
#pragma unroll
            for (int rr = 0; rr < 2; ++rr) { float o[8];
#pragma unroll
                for (int j = 0; j < 8; ++j) { const int sh = (j & 1) * 16; const int q = j >> 1;
                    const float a0 = __builtin_bit_cast(float, ((z[u][rr][q] >> sh) & 0xffffu) << 16), a1 = __builtin_bit_cast(float, ((z[u][rr + 1][q] >> sh) & 0xffffu) << 16), a2 = __builtin_bit_cast(float, ((z[u][rr + 2][q] >> sh) & 0xffffu) << 16);
                    const float cbf = __builtin_bit_cast(float, ((cbv[u][rr][q] >> sh) & 0xffffu) << 16);
                    const float x0 = j < 4 ? w0a[j & 3] : w0b[j & 3], x1 = j < 4 ? w1a[j & 3] : w1b[j & 3], x2 = j < 4 ? w2a[j & 3] : w2b[j & 3];
                    o[j] = cbf * (x0 * a0 + x1 * a1 + x2 * a2); }
                v4u w; w.x = pk2(o[0], o[1]); w.y = pk2(o[2], o[3]); w.z = pk2(o[4], o[5]); w.w = pk2(o[6], o[7]);
                *(GAS v4u*)(mix + (size_t)(R + rr) * DM + c0) = w; } } }
    }
}

namespace att {
#ifndef ATT_SG
#define ATT_SG 3
#endif
__device__ __forceinline__ int crow(int r, int hi) { return (r & 3) + 8 * (r >> 2) + 4 * hi; }
typedef short v4i16_t __attribute__((ext_vector_type(4)));
__device__ __forceinline__ s16x4 vtr(const LAS unsigned char* p) { return __builtin_bit_cast(s16x4, __builtin_amdgcn_ds_read_tr16_b64_v4i16((LAS v4i16_t*)p)); }
__device__ __forceinline__ unsigned cvtpk(float lo, float hi) { typedef float f2 __attribute__((ext_vector_type(2))); typedef __bf16 b2 __attribute__((ext_vector_type(2))); f2 v = {lo, hi}; b2 b = __builtin_convertvector(v, b2); return __builtin_bit_cast(unsigned, b); }

struct Par { const bf16* Qb; const bf16* Kb; const bf16* Vb; bf16* mix; const float* subg; float negM, lam; const bf16* cb; const bf16* ccx; const float* cw; bool conv; };

__device__ __forceinline__ void dma16(const GAS unsigned char* gbase, unsigned voff, LAS unsigned char* lds_dst) {
    asm volatile("s_mov_b32 m0, %2\n\ts_nop 0\n\tglobal_load_lds_dwordx4 %0, %1" :: "v"(voff), "s"(gbase), "s"((unsigned)(size_t)lds_dst) : "memory");
}
#define ATT_WAITBAR() do { asm volatile("s_waitcnt vmcnt(0) lgkmcnt(0)" ::: "memory"); __builtin_amdgcn_s_barrier(); asm volatile("" ::: "memory"); } while (0)
#define ATT_WAITBAR4() do { if (VAR == 6 || VAR == 7) break; asm volatile("s_waitcnt vmcnt(4)" ::: "memory"); __builtin_amdgcn_s_barrier(); asm volatile("" ::: "memory"); } while (0)

__device__ __forceinline__ void qkt(f32x16& p0, f32x16& p1, const LAS unsigned char* kb, const bf16x8 (&qf)[4]) {
    const f32x16 zero = {0.f, 0.f, 0.f, 0.f, 0.f, 0.f, 0.f, 0.f, 0.f, 0.f, 0.f, 0.f, 0.f, 0.f, 0.f, 0.f};
#pragma unroll
    for (int d0 = 0; d0 < 4; ++d0) {
        const bf16x8 a0 = *(const LAS bf16x8*)(kb + d0 * 2048), a1 = *(const LAS bf16x8*)(kb + d0 * 2048 + 512);
        if (d0 == 0) { p0 = __builtin_amdgcn_mfma_f32_32x32x16_bf16(a0, qf[0], zero, 0, 0, 0); p1 = __builtin_amdgcn_mfma_f32_32x32x16_bf16(a1, qf[0], zero, 0, 0, 0); }
        else { p0 = __builtin_amdgcn_mfma_f32_32x32x16_bf16(a0, qf[d0], p0, 0, 0, 0); p1 = __builtin_amdgcn_mfma_f32_32x32x16_bf16(a1, qf[d0], p1, 0, 0, 0); }
    }
}
__device__ __forceinline__ void band_mask(f32x16& p0, f32x16& p1, int lim, int hi) {
    int lim2 = lim - 4 * hi; asm volatile("" : "+v"(lim2));
#pragma unroll
    for (int r = 0; r < 16; ++r) { const int c = (r & 3) + 8 * (r >> 2); if (c > lim2) p0[r] = -INFINITY; if (c + 32 > lim2) p1[r] = -INFINITY; }
}
template <bool SHIFT> __device__ __forceinline__ void softmax_pack(f32x16& p0, f32x16& p1, float& lsum, bf16x8 (&pw)[4], float negM) {
#pragma unroll
    for (int r = 0; r < 16; ++r) { p0[r] = __builtin_amdgcn_exp2f(SHIFT ? p0[r] + negM : p0[r]); lsum += p0[r]; }
#pragma unroll
    for (int r = 0; r < 16; ++r) { p1[r] = __builtin_amdgcn_exp2f(SHIFT ? p1[r] + negM : p1[r]); lsum += p1[r]; }
    v4u w;
    w.x = cvtpk(p0[0], p0[1]); w.y = cvtpk(p0[2], p0[3]); w.z = cvtpk(p0[4], p0[5]); w.w = cvtpk(p0[6], p0[7]); pw[0] = __builtin_bit_cast(bf16x8, w);
    w.x = cvtpk(p0[8], p0[9]); w.y = cvtpk(p0[10], p0[11]); w.z = cvtpk(p0[12], p0[13]); w.w = cvtpk(p0[14], p0[15]); pw[1] = __builtin_bit_cast(bf16x8, w);
    w.x = cvtpk(p1[0], p1[1]); w.y = cvtpk(p1[2], p1[3]); w.z = cvtpk(p1[4], p1[5]); w.w = cvtpk(p1[6], p1[7]); pw[2] = __builtin_bit_cast(bf16x8, w);
    w.x = cvtpk(p1[8], p1[9]); w.y = cvtpk(p1[10], p1[11]); w.z = cvtpk(p1[12], p1[13]); w.w = cvtpk(p1[14], p1[15]); pw[3] = __builtin_bit_cast(bf16x8, w);
}
__device__ __forceinline__ void pv(f32x16 (&o)[4], const LAS unsigned char* vb, const bf16x8 (&pw)[4]) {
#pragma unroll
    for (int ks = 0; ks < 4; ++ks)
#pragma unroll
        for (int db = 0; db < 4; ++db) {
            const s16x4 lo = vtr(vb + db * 4096 + ks * 1024), hh = vtr(vb + db * 4096 + ks * 1024 + 512);
            const bf16x8 vf = (bf16x8){lo[0], lo[1], lo[2], lo[3], hh[0], hh[1], hh[2], hh[3]};
            o[db] = __builtin_amdgcn_mfma_f32_32x32x16_bf16(pw[ks], vf, o[db], 0, 0, 0);
        }
}

struct DmaTile { const GAS unsigned char* k; const GAS unsigned char* v; LAS unsigned char* d; unsigned l16; };
template <bool SHIFT, bool MASK, int VAR>
__device__ __forceinline__ void att_step(f32x16 (&o)[4], const v4u (&pin)[4], v4u (&pout)[4], float& lsum, const LAS unsigned char* kb, const LAS unsigned char* vb, const LAS unsigned char* vbn,
                                         s16x4 (&vl0)[4], s16x4 (&vh0)[4], const bf16x8 (&qf)[4], float negM, int lim, int hi, const DmaTile& dt) {
#define SBAR() __builtin_amdgcn_sched_barrier(0)
#define VOFF(m_) ((((m_) & 3) * 4096) + (((m_) >> 2) * 1024))
#define SOFTPAIR(j_) do { float e0, e1; if ((j_) < 8) { e0 = p0[2 * (j_)]; e1 = p0[2 * (j_) + 1]; } else { e0 = p1[2 * (j_) - 16]; e1 = p1[2 * (j_) - 15]; } \
        if (SHIFT) { e0 += negM; e1 += negM; } \
        if (VAR != 1) { e0 = __builtin_amdgcn_exp2f(e0); e1 = __builtin_amdgcn_exp2f(e1); lsum += e0; lsum += e1; pout[(j_) >> 2][(j_) & 3] = cvtpk(e0, e1); } \
        else { pout[(j_) >> 2][(j_) & 3] = __builtin_bit_cast(unsigned, e0) ^ __builtin_bit_cast(unsigned, e1); } } while (0)
    const f32x16 zero = {0.f, 0.f, 0.f, 0.f, 0.f, 0.f, 0.f, 0.f, 0.f, 0.f, 0.f, 0.f, 0.f, 0.f, 0.f, 0.f};
    bf16x8 kf[8];
#pragma unroll
    for (int d0 = 0; d0 < 4; ++d0) { kf[2 * d0] = *(const LAS bf16x8*)(kb + d0 * 2048); kf[2 * d0 + 1] = *(const LAS bf16x8*)(kb + d0 * 2048 + 512); }
    s16x4 vl[16], vh[16];
#pragma unroll
    for (int m = 0; m < 4; ++m) { vl[m] = vl0[m]; vh[m] = vh0[m]; }
#pragma unroll
    for (int m = 4; m < 8; ++m) { vl[m] = vtr(vb + VOFF(m)); vh[m] = vtr(vb + VOFF(m) + 512); }
    SBAR();
#pragma unroll
    for (int m = 0; m < 4; ++m) {
        const bf16x8 vf = (bf16x8){vl[m][0], vl[m][1], vl[m][2], vl[m][3], vh[m][0], vh[m][1], vh[m][2], vh[m][3]};
        if (VAR != 2) o[m & 3] = __builtin_amdgcn_mfma_f32_32x32x16_bf16(__builtin_bit_cast(bf16x8, pin[m >> 2]), vf, o[m & 3], 0, 0, 0); else asm volatile("" :: "v"(vf));
    }
    SBAR();
    f32x16 p0, p1;
    if (MASK) {
        p0 = __builtin_amdgcn_mfma_f32_32x32x16_bf16(kf[0], qf[0], zero, 0, 0, 0); p1 = __builtin_amdgcn_mfma_f32_32x32x16_bf16(kf[1], qf[0], zero, 0, 0, 0);
#pragma unroll
        for (int d0 = 1; d0 < 4; ++d0) { p0 = __builtin_amdgcn_mfma_f32_32x32x16_bf16(kf[2 * d0], qf[d0], p0, 0, 0, 0); p1 = __builtin_amdgcn_mfma_f32_32x32x16_bf16(kf[2 * d0 + 1], qf[d0], p1, 0, 0, 0); }
        band_mask(p0, p1, lim, hi);
        SBAR();
    } else {
        p0 = __builtin_amdgcn_mfma_f32_32x32x16_bf16(kf[0], qf[0], zero, 0, 0, 0);
#pragma unroll
        for (int d0 = 1; d0 < 4; ++d0) p0 = __builtin_amdgcn_mfma_f32_32x32x16_bf16(kf[2 * d0], qf[d0], p0, 0, 0, 0);
        SBAR();
        p1 = __builtin_amdgcn_mfma_f32_32x32x16_bf16(kf[1], qf[0], zero, 0, 0, 0); dma16(dt.k, dt.l16, dt.d); SOFTPAIR(0); SBAR();
        p1 = __builtin_amdgcn_mfma_f32_32x32x16_bf16(kf[3], qf[1], p1, 0, 0, 0); dma16(dt.k + 8192, dt.l16, dt.d + 8192); SOFTPAIR(1); SBAR();
        p1 = __builtin_amdgcn_mfma_f32_32x32x16_bf16(kf[5], qf[2], p1, 0, 0, 0); dma16(dt.v, dt.l16, dt.d + 16384); SOFTPAIR(2); SBAR();
        p1 = __builtin_amdgcn_mfma_f32_32x32x16_bf16(kf[7], qf[3], p1, 0, 0, 0); dma16(dt.v + 8192, dt.l16, dt.d + 24576); SOFTPAIR(3); SBAR();
    }
#pragma unroll
    for (int m = 4; m < 16; ++m) {
        if (m + 4 < 16) { if (VAR == 5 || VAR == 7) { vl[m + 4] = vl[m]; vh[m + 4] = vh[m]; } else { vl[m + 4] = vtr(vb + VOFF(m + 4)); vh[m + 4] = vtr(vb + VOFF(m + 4) + 512); } }
        else { vl0[m - 12] = vtr(vbn + VOFF(m - 12)); vh0[m - 12] = vtr(vbn + VOFF(m - 12) + 512); }
        const bf16x8 vf = (bf16x8){vl[m][0], vl[m][1], vl[m][2], vl[m][3], vh[m][0], vh[m][1], vh[m][2], vh[m][3]};
        if (VAR != 2) o[m & 3] = __builtin_amdgcn_mfma_f32_32x32x16_bf16(__builtin_bit_cast(bf16x8, pin[m >> 2]), vf, o[m & 3], 0, 0, 0); else asm volatile("" :: "v"(vf));
        if (MASK) { if (m < 8) { SOFTPAIR(2 * (m - 4)); SOFTPAIR(2 * (m - 4) + 1); } else { SOFTPAIR(m); } }
        else { SOFTPAIR(m); }
        SBAR();
    }
#undef SOFTPAIR
#undef VOFF
#undef SBAR
}

__device__ __forceinline__ void conv_slice(const Par& P, int b, int head, int qb, int tm) {
    asm volatile("" : "+v"(tm));
    const int cg = tm & 15, c0 = 128 * head + 8 * cg;
    const float* cw = P.cw;
    const f32x4 w0a = *(const f32x4*)(cw + c0), w0b = *(const f32x4*)(cw + c0 + 4), w1a = *(const f32x4*)(cw + CONVW + c0), w1b = *(const f32x4*)(cw + CONVW + c0 + 4),
                w2a = *(const f32x4*)(cw + 2 * CONVW + c0), w2b = *(const f32x4*)(cw + 2 * CONVW + c0 + 4);
#pragma unroll
    for (int h2 = 0; h2 < 2; ++h2) {
        v4u z[2][4], cbv[2][2];
#pragma unroll
        for (int u = 0; u < 2; ++u) { const int rp = (tm >> 4) + 16 * (2 * h2 + u), i = 128 * qb + 2 * rp; const size_t R = (size_t)b * SEQ + i;
            const bf16* zp = P.ccx + ((size_t)(b * CCXROWS + i)) * CONVW + c0;
#pragma unroll
            for (int r = 0; r < 4; ++r) z[u][r] = *(const GAS v4u*)(zp + r * CONVW);
            cbv[u][0] = *(const GAS v4u*)(P.cb + R * CONVW + c0); cbv[u][1] = *(const GAS v4u*)(P.cb + (R + 1) * CONVW + c0); }
#pragma unroll
        for (int u = 0; u < 2; ++u) { const int rp = (tm >> 4) + 16 * (2 * h2 + u), i = 128 * qb + 2 * rp; const size_t R = (size_t)b * SEQ + i;
#pragma unroll
            for (int rr = 0; rr < 2; ++rr) { float o[8];
#pragma unroll
                for (int j = 0; j < 8; ++j) { const int sh = (j & 1) * 16; const int q = j >> 1;
                    const float a0 = __builtin_bit_cast(float, ((z[u][rr][q] >> sh) & 0xffffu) << 16), a1 = __builtin_bit_cast(float, ((z[u][rr + 1][q] >> sh) & 0xffffu) << 16), a2 = __builtin_bit_cast(float, ((z[u][rr + 2][q] >> sh) & 0xffffu) << 16);
                    const float cbf = __builtin_bit_cast(float, ((cbv[u][rr][q] >> sh) & 0xffffu) << 16);
                    const float x0 = j < 4 ? w0a[j & 3] : w0b[j & 3], x1 = j < 4 ? w1a[j & 3] : w1b[j & 3], x2 = j < 4 ? w2a[j & 3] : w2b[j & 3];
                    o[j] = cbf * (x0 * a0 + x1 * a1 + x2 * a2); }
                v4u w; w.x = pk2(o[0], o[1]); w.y = pk2(o[2], o[3]); w.z = pk2(o[4], o[5]); w.w = pk2(o[6], o[7]);
                *(GAS v4u*)(P.mix + (R + rr) * DM + c0) = w; } }
        asm volatile("" ::: "memory");
    }
}

__device__ __forceinline__ void att_prefetch(LAS unsigned char* lds, const Par& P, int b, int head, int qb, bf16x8 (&qfn)[4]) {
    int tid = threadIdx.x; asm volatile("" : "+v"(tid));
    const int lane = tid & 63, wid = __builtin_amdgcn_readfirstlane(tid >> 6), r32 = lane & 31, hi = lane >> 5, rg = wid >> 1, mp = wid & 1;
    const GAS unsigned char* kg = (const GAS unsigned char*)(P.Kb + k_off(b, head, 0, 0, 0, 0)) + wid * 1024;
    const GAS unsigned char* vg = (const GAS unsigned char*)(P.Vb + v_off(b, head, 0, 0, 0, 0)) + wid * 1024;
    const unsigned l16 = (unsigned)lane * 16u; LAS unsigned char* ldw = lds + wid * 1024;
#pragma unroll
    for (int t = 0; t < 2; ++t) { LAS unsigned char* d_ = ldw + (2 + t) * 32768; const GAS unsigned char* k_ = kg + (size_t)t * 16384; const GAS unsigned char* v_ = vg + (size_t)t * 16384;
        dma16(k_, l16, d_); dma16(k_ + 8192, l16, d_ + 8192); dma16(v_, l16, d_ + 16384); dma16(v_ + 8192, l16, d_ + 24576); }
#pragma unroll
    for (int d0 = 0; d0 < 4; ++d0) qfn[d0] = *(const GAS bf16x8*)(P.Qb + q_off(b, head, mp, qb * 128 + 32 * rg, 2 * d0 + hi) + r32 * 8);
}

template <bool SHIFT, int VAR> __device__ __forceinline__ void attn_unit(LAS unsigned char* lds, const Par& P, int b, int head, int qb, bf16x8 (&qfn)[4], bool has_next, int nb, int nhead, int nqb) {
    const int tid = threadIdx.x, lane = tid & 63, wid = __builtin_amdgcn_readfirstlane(tid >> 6), r32 = lane & 31, hi = lane >> 5, rg = wid >> 1, mp = wid & 1;
    const int i0 = qb * 128, iq = i0 + 32 * rg + r32;
    const int ntl = 2 * qb + 3, mylast = 2 * qb + 1 + (rg >= 2 ? 1 : 0);
    const GAS unsigned char* kg = (const GAS unsigned char*)(P.Kb + k_off(b, head, 0, 0, 0, 0)) + wid * 1024;
    const GAS unsigned char* vg = (const GAS unsigned char*)(P.Vb + v_off(b, head, 0, 0, 0, 0)) + wid * 1024;
    const unsigned l16 = (unsigned)lane * 16u;
    LAS unsigned char* ldw = lds + wid * 1024;
#define ATT_DMA(t_, slot_) do { if (VAR == 3 || VAR == 6 || VAR == 7) break; const size_t go_ = (VAR == 4) ? (size_t)0 : (size_t)(t_) * 16384; LAS unsigned char* d_ = ldw + (slot_) * 32768; \
        const GAS unsigned char* k_ = kg + go_; const GAS unsigned char* v_ = vg + go_; \
        dma16(k_, l16, d_); dma16(k_ + 8192, l16, d_ + 8192); dma16(v_, l16, d_ + 16384); dma16(v_ + 8192, l16, d_ + 24576); } while (0)
    ATT_DMA(2, 0);
    bf16x8 qf[4];
#pragma unroll
    for (int d0 = 0; d0 < 4; ++d0) qf[d0] = qfn[d0];
    f32x16 o[4]; const float negM = P.negM;
#pragma unroll
    for (int d = 0; d < 4; ++d)
#pragma unroll
        for (int r = 0; r < 16; ++r) o[d][r] = 0.f;
    float lsum = 0.f;
    const int koff = mp * 8192 + hi * 1024 + r32 * 16, voff = 16384 + ((lane >> 4) & 1) * 32 + (lane & 3) * 8 + (4 * hi + ((lane & 15) >> 2)) * 64;
    asm volatile("s_waitcnt vmcnt(4) lgkmcnt(0)" ::: "memory"); __builtin_amdgcn_s_barrier(); asm volatile("" ::: "memory");
    bf16x8 pw0[4];
    {
        f32x16 p0, p1; qkt(p0, p1, lds + 2 * 32768 + koff, qf);
#pragma unroll
        for (int r = 0; r < 16; ++r) { p0[r] = -INFINITY; if ((r & 3) + 8 * (r >> 2) < 16 - 4 * hi) p1[r] = -INFINITY; }
        softmax_pack<SHIFT>(p0, p1, lsum, pw0, negM);
    }
    if (wid >= 4) __builtin_amdgcn_s_setprio(1);
    int s_cur = 2, s_nxt = 3, s_nx2 = 0, s_fre = 1;
    v4u pw[4], pq[4];
#pragma unroll
    for (int i = 0; i < 4; ++i) pw[i] = __builtin_bit_cast(v4u, pw0[i]);
#define ATT_ROT4() do { const int x_ = s_cur; s_cur = s_nxt; s_nxt = s_nx2; s_nx2 = s_fre; s_fre = x_; } while (0)
#define ATT_KB (lds + s_nxt * 32768 + koff)
#define ATT_VB (lds + s_cur * 32768 + voff)
#define ATT_VBN (lds + s_nxt * 32768 + voff)
    s16x4 vl0[4], vh0[4];
#pragma unroll
    for (int m = 0; m < 4; ++m) { vl0[m] = vtr(ATT_VB + (m & 3) * 4096); vh0[m] = vtr(ATT_VB + (m & 3) * 4096 + 512); }
    int t = 0;
    for (; t < 2 * qb; t += 2) {
        att_step<SHIFT, false, VAR>(o, pw, pq, lsum, ATT_KB, ATT_VB, ATT_VBN, vl0, vh0, qf, negM, 0, hi, DmaTile{kg + (size_t)(t + 3) * 16384, vg + (size_t)(t + 3) * 16384, ldw + s_fre * 32768, l16}); ATT_WAITBAR4(); ATT_ROT4();
        att_step<SHIFT, false, VAR>(o, pq, pw, lsum, ATT_KB, ATT_VB, ATT_VBN, vl0, vh0, qf, negM, 0, hi, DmaTile{kg + (size_t)(t + 4) * 16384, vg + (size_t)(t + 4) * 16384, ldw + s_fre * 32768, l16}); ATT_WAITBAR4(); ATT_ROT4();
    }
    att_step<SHIFT, true, VAR>(o, pw, pq, lsum, ATT_KB, ATT_VB, ATT_VBN, vl0, vh0, qf, negM, iq - 64 * t, hi, DmaTile{kg, vg, ldw, l16}); ATT_WAITBAR(); ATT_ROT4(); ++t;
    att_step<SHIFT, true, VAR>(o, pq, pw, lsum, ATT_KB, ATT_VB, ATT_VBN, vl0, vh0, qf, negM, iq - 64 * t, hi, DmaTile{kg, vg, ldw, l16}); ATT_WAITBAR(); ATT_ROT4(); ++t;
    { bf16x8 pl[4];
#pragma unroll
      for (int i = 0; i < 4; ++i) pl[i] = __builtin_bit_cast(bf16x8, pw[i]);
      pv(o, ATT_VB, pl); }
    ATT_WAITBAR();
    if (has_next) att_prefetch(lds, P, nb, nhead, nqb, qfn);
#undef ATT_ROT4
#undef ATT_KB
#undef ATT_VB
#undef ATT_VBN
#undef ATT_DMA
    __builtin_amdgcn_s_setprio(0);
    { auto rr = __builtin_amdgcn_permlane32_swap(__float_as_uint(lsum), __float_as_uint(lsum), false, false); lsum = __uint_as_float(rr[0]) + __uint_as_float(rr[1]); }
    int le = lane; asm volatile("" : "+v"(le));
    const int r32e = le & 31, hie = le >> 5;
    LAS float* lsc = (LAS float*)(lds + 135168) + wid * 32;
    LAS float* comb = (LAS float*)lds + rg * 4096 + (4 * hie) * 128 + r32e;
    if (hie == 0) lsc[r32e] = lsum;
    LDS_WAIT(); asm volatile("" ::: "memory");
    const float sc = mp ? P.lam : 1.0f;
#pragma unroll
    for (int r = 0; r < 16; ++r) { const float rl = sc * __builtin_amdgcn_rcpf(lsc[4 * hie + (r & 3) + 8 * (r >> 2)]);
#pragma unroll
        for (int db = 0; db < 4; ++db) o[db][r] *= rl; }
    if (mp == 1) {
#pragma unroll
        for (int r = 0; r < 16; ++r)
#pragma unroll
            for (int db = 0; db < 4; ++db) comb[((r & 3) + 8 * (r >> 2)) * 128 + 32 * db] = o[db][r];
    }
    __syncthreads();
    if (mp == 0) {
        LAS unsigned short* yst = (LAS unsigned short*)(lds + rg * 16384) + (4 * hie) * 128 + r32e;
        float sg[4];
#pragma unroll
        for (int db = 0; db < 4; ++db) sg[db] = P.subg[32 * db + r32e];
        const int x1 = (le ^ 1) << 2, x2 = (le ^ 2) << 2, x4 = (le ^ 4) << 2, x8 = (le ^ 8) << 2, x16 = (le ^ 16) << 2;
#pragma unroll
        for (int r = 0; r < 16; ++r) { const int qc = (r & 3) + 8 * (r >> 2);
#pragma unroll
            for (int db = 0; db < 4; ++db) o[db][r] -= comb[qc * 128 + 32 * db]; }
        LDS_WAIT(); asm volatile("" ::: "memory");
#pragma unroll
        for (int r = 0; r < 16; ++r) { float s = 0.f; const int qc = (r & 3) + 8 * (r >> 2);
#pragma unroll
            for (int db = 0; db < 4; ++db) s += o[db][r] * o[db][r];
            s += __builtin_bit_cast(float, __builtin_amdgcn_ds_bpermute(x1, __builtin_bit_cast(int, s))); s += __builtin_bit_cast(float, __builtin_amdgcn_ds_bpermute(x2, __builtin_bit_cast(int, s)));
            s += __builtin_bit_cast(float, __builtin_amdgcn_ds_bpermute(x4, __builtin_bit_cast(int, s))); s += __builtin_bit_cast(float, __builtin_amdgcn_ds_bpermute(x8, __builtin_bit_cast(int, s)));
            s += __builtin_bit_cast(float, __builtin_amdgcn_ds_bpermute(x16, __builtin_bit_cast(int, s)));
            s = rsqrtf(s * (1.0f / 128.0f) + EPS) * 0.8f;
#pragma unroll
            for (int db = 0; db < 4; ++db) yst[qc * 128 + 32 * db] = (unsigned short)f2bf(o[db][r] * s * sg[db]); }
        LDS_WAIT(); asm volatile("" ::: "memory");
        bf16* orow = P.mix + ((size_t)(b * SEQ + i0 + 32 * rg)) * DM + 512 + head * 128;
        const LAS unsigned short* ysr = (const LAS unsigned short*)(lds + rg * 16384);
#pragma unroll
        for (int j = 0; j < 8; ++j) { const int q = 4 * j + (le >> 4), ch = le & 15;
            const v4u v = *(const LAS v4u*)(ysr + q * 128 + ch * 8);
            *(GAS v4u*)(orow + (size_t)q * DM + ch * 8) = v; }
    } else if (P.conv) conv_slice(P, b, head, qb, rg * 64 + le);
    __syncthreads();
}

__device__ __forceinline__ void attn_phase(Frame& F, const Args& a, unsigned char* ws, bool do_conv) {
    Par P; P.Qb = (const bf16*)(ws + WS_Q); P.Kb = (const bf16*)(ws + WS_K); P.Vb = (const bf16*)(ws + WS_V); P.mix = (bf16*)(ws + WS_MIX); P.subg = a.in[11];
    P.cb = (const bf16*)(ws + WS_CB); P.ccx = (const bf16*)(ws + WS_CCX); P.cw = a.in[4]; P.conv = do_conv;
#if defined(ATT_VAR)
    if (a.ph_hi - a.ph_lo == 1) P.mix = (bf16*)(ws + WS_END);
#endif
    const int nun = (F.G == 256) ? 4 : (1024 - F.vcu + F.G - 1) / F.G;
#define ATT_UNIT(k_, bh_, qb_) do { if (F.G == 256) { const int s_ = F.vcu & 15; bh_ = F.vcu >> 4; qb_ = ((k_) == 0) ? s_ : ((k_) == 1) ? 31 - s_ : ((k_) == 2) ? 32 + s_ : 63 - s_; }     \
        else { const int uix = F.vcu + (k_) * F.G; bh_ = uix >> 6; qb_ = uix & 63; } } while (0)
    bf16x8 qfn[4];
    { int bh, qb; ATT_UNIT(0, bh, qb); if (nun > 0) att_prefetch(F.lds, P, bh >> 2, bh & 3, qb, qfn); }
    const float* gq = a.in[5]; const float* gk = a.in[6];
    const float d1 = wave_sum(a.in[7][F.lane] * a.in[8][F.lane]), d2 = wave_sum(a.in[9][F.lane] * a.in[10][F.lane]);
    const float lam = __expf(d1) - __expf(d2) + 0.2f;
    const float mq = wave_max(fabsf(gq[F.lane])), mk = wave_max(fabsf(gk[F.lane]));
    P.negM = -(8.0f * mq * mk * 1.4426950408889634f); P.lam = lam;
    for (int k = 0; k < nun; ++k) {
        int bh, qb, nbh = 0, nqb = 0; ATT_UNIT(k, bh, qb); const bool hn = k + 1 < nun; if (hn) ATT_UNIT(k + 1, nbh, nqb);
#if defined(ATT_VAR)
        if (a.ph_hi - a.ph_lo == 1) { attn_unit<false, ATT_VAR>(F.lds, P, bh >> 2, bh & 3, qb, qfn, hn, nbh >> 2, nbh & 3, nqb); continue; }
#endif
        if (P.negM >= -100.0f) attn_unit<false, 0>(F.lds, P, bh >> 2, bh & 3, qb, qfn, hn, nbh >> 2, nbh & 3, nqb); else attn_unit<true, 0>(F.lds, P, bh >> 2, bh & 3, qb, qfn, hn, nbh >> 2, nbh & 3, nqb);
    }
#undef ATT_UNIT
}
}

typedef float f32x4v __attribute__((ext_vector_type(4)));
__device__ __forceinline__ void router_phase(Frame& F, const Args& a, unsigned char* ws) {
    const bf16* hb = (const bf16*)(ws + WS_XB); const v4u* wrB = (const v4u*)(ws + WS_WR); float* rstd2 = (float*)(ws + WS_RSTD2);
    const float* b_rg = a.in[15]; const float* b_re = a.in[17];
    int* rowpair = (int*)(ws + WS_ROWPAIR); float* rowrs = (float*)(ws + WS_ROWRS); unsigned* cnt = (unsigned*)(F.ctl + CW_CNT);
    LAS float* lgt = (LAS float*)(F.lds + 0);
    LAS int* pe = (LAS int*)(F.lds + 32768);
    LAS float* pg = (LAS float*)(F.lds + 32768 + 1024);
    LAS int* prk = (LAS int*)(F.lds + 32768 + 2048);
    LAS int* hist = (LAS int*)(F.lds + 32768 + 3072);
    LAS float* lgt2 = (LAS float*)(F.lds + 36864);
    const int lane = F.lane, w = F.wave;
    for (int blk = F.vcu; blk < NTOK / 128; blk += F.G) {
        if (F.tid < 64) hist[F.tid] = 0;
        {
            const int tg = w & 3, kh2 = w >> 2; LAS float* const lgw = kh2 ? lgt2 : lgt;
            const int tok0 = blk * 128 + 32 * tg;
            typedef unsigned v2u __attribute__((ext_vector_type(2)));
            const GAS v4u* ap0 = (const GAS v4u*)(hb + (size_t)(tok0 + (lane & 15)) * DM) + (lane >> 4) + kh2 * (DM / 16);
            const GAS v4u* ap1 = ap0 + 16 * (DM / 8);
            const GAS v4u* bp = (const GAS v4u*)wrB + lane + kh2 * (8 * 768);
            f32x4 acc[2][3]; float sq0 = 0.f, sq1 = 0.f;
#pragma unroll
            for (int r = 0; r < 2; ++r)
#pragma unroll
                for (int c = 0; c < 3; ++c) acc[r][c] = (f32x4){0.f, 0.f, 0.f, 0.f};
            v4u A0[2][2], A1[2][2], B0[2][3][2], B1[2][3][2];
#define RT_LDA(dst, bt) do { _Pragma("unroll") for (int p_ = 0; p_ < 2; ++p_) { dst[p_][0] = ap0[((bt) * 2 + p_) * 4]; dst[p_][1] = ap1[((bt) * 2 + p_) * 4]; } } while (0)
#define RT_LDB(dst, bt) do { _Pragma("unroll") for (int p_ = 0; p_ < 2; ++p_) _Pragma("unroll") for (int c_ = 0; c_ < 3; ++c_) _Pragma("unroll") for (int s_ = 0; s_ < 2; ++s_) dst[p_][c_][s_] = bp[(((((bt) * 2 + p_) * 3 + c_) * 2 + s_)) * 64]; } while (0)
            RT_LDA(A0, 0); RT_LDB(B0, 0);
#pragma nounroll
            for (int bt = 0; bt < 8; ++bt) {
                const int b1 = bt + 1 < 8 ? bt + 1 : 7;
                RT_LDA(A1, b1); RT_LDB(B1, b1); __builtin_amdgcn_sched_barrier(0);
#pragma unroll
                for (int p = 0; p < 2; ++p) {
                    const v4u q0 = A0[p][0], q1 = A0[p][1];
#pragma unroll
                    for (int i = 0; i < 4; ++i) { const float l0 = __builtin_bit_cast(float, q0[i] << 16), h0 = __builtin_bit_cast(float, q0[i] & 0xffff0000u), l1 = __builtin_bit_cast(float, q1[i] << 16), h1 = __builtin_bit_cast(float, q1[i] & 0xffff0000u);
                        sq0 += l0 * l0 + h0 * h0; sq1 += l1 * l1 + h1 * h1; }
                    const bf16x8 a0 = __builtin_bit_cast(bf16x8, q0), a1 = __builtin_bit_cast(bf16x8, q1);
#pragma unroll
                    for (int s_ = 0; s_ < 2; ++s_)
#pragma unroll
                        for (int c = 0; c < 3; ++c) { const bf16x8 bv = __builtin_bit_cast(bf16x8, B0[p][c][s_]);
                            acc[0][c] = __builtin_amdgcn_mfma_f32_16x16x32_bf16(a0, bv, acc[0][c], 0, 0, 0); acc[1][c] = __builtin_amdgcn_mfma_f32_16x16x32_bf16(a1, bv, acc[1][c], 0, 0, 0); }
                }
                __builtin_amdgcn_sched_barrier(0);
#pragma unroll
                for (int p = 0; p < 2; ++p) { A0[p][0] = A1[p][0]; A0[p][1] = A1[p][1];
#pragma unroll
                    for (int c = 0; c < 3; ++c) { B0[p][c][0] = B1[p][c][0]; B0[p][c][1] = B1[p][c][1]; } }
            }
#undef RT_LDA
#undef RT_LDB
            sq0 += __shfl_xor(sq0, 16); sq0 += __shfl_xor(sq0, 32); sq1 += __shfl_xor(sq1, 16); sq1 += __shfl_xor(sq1, 32);
#pragma unroll
            for (int r = 0; r < 2; ++r)
#pragma unroll
                for (int c = 0; c < 3; ++c)
#pragma unroll
                    for (int q = 0; q < 4; ++q) lgw[(32 * tg + 16 * r + 4 * (lane >> 4) + q) * 49 + 16 * c + (lane & 15)] = acc[r][c][q];
            if (lane < 16) { lgw[(32 * tg + lane) * 49 + 48] = sq0; lgw[(32 * tg + 16 + lane) * 49 + 48] = sq1; }
        }
        __syncthreads();
        if (w < 4) {
            if (lane < 32) {
                const int tl = 32 * w + lane; const LAS float* lg = lgt + tl * 49; const LAS float* lg2 = lgt2 + tl * 49; const float rs = rsqrtf((lg[48] + lg2[48]) * (1.0f / DM) + EPS);
                lgt[tl * 49 + 48] = rs;
                rstd2[blk * 128 + tl] = rs;
                int gi = 0; float gl[4]; float gm; const f32x4 brg = *(const f32x4*)b_rg;
#pragma unroll
                for (int j = 0; j < 4; ++j) gl[j] = (lg[j] + lg2[j]) * rs + brg[j];
                gm = gl[0];
#pragma unroll
                for (int j = 1; j < 4; ++j) if (gl[j] > gm) { gm = gl[j]; gi = j; }
                float gs = 0.f;
#pragma unroll
                for (int j = 0; j < 4; ++j) gs += __expf(gl[j] - gm);
                const float gval = 1.0f / gs;
                int e1 = 0, e2 = 0; float m1 = -INFINITY, m2 = -INFINITY;
                const f32x4 bre0 = *(const f32x4*)(b_re + gi * 8), bre1 = *(const f32x4*)(b_re + gi * 8 + 4);
#pragma unroll
                for (int j = 0; j < 8; ++j) { const float x = (lg[4 + gi * 8 + j] + lg2[4 + gi * 8 + j]) * rs + (j < 4 ? bre0[j & 3] : bre1[j & 3]);
                    if (x > m1) { m2 = m1; e2 = e1; m1 = x; e1 = j; } else if (x > m2) { m2 = x; e2 = j; } }
                const float r = __expf(m2 - m1), g1v = gval / (1.0f + r), g2v = gval * r / (1.0f + r);
                pe[2 * tl] = gi * 8 + e1; pg[2 * tl] = g1v; pe[2 * tl + 1] = gi * 8 + e2; pg[2 * tl + 1] = g2v;
            }
        }
        __syncthreads();
        if (F.tid < 256) prk[F.tid] = atomicAdd((int*)&hist[pe[F.tid]], 1);
        __syncthreads();
        if (F.tid < 32) hist[32 + F.tid] = (int)__hip_atomic_fetch_add(cnt + 16 * F.tid, (unsigned)hist[F.tid], __ATOMIC_RELAXED, __HIP_MEMORY_SCOPE_AGENT);
        __syncthreads();
        if (F.tid < 256) { const int e = pe[F.tid], pos = hist[32 + e] + prk[F.tid];
            rowpair[(size_t)e * CAP + pos] = (int)((unsigned)(2 * (blk * 128 + (F.tid >> 1)) + (F.tid & 1)) | (f2bf(pg[F.tid]) << 16));
            rowrs[(size_t)e * CAP + pos] = lgt[(F.tid >> 1) * 49 + 48]; }
        __syncthreads();
    }
}

__device__ __forceinline__ MoeTab moe_tables(Frame& F, bool reuse) {
    LAS int* bs = (LAS int*)(F.lds + TAB_OFF); LAS int* cn = (LAS int*)(F.lds + TAB_OFF + 256); LAS unsigned char* b2e = (LAS unsigned char*)(F.lds + TAB_OFF + 512);
    if (!reuse) {
        __syncthreads();
        if (F.tid < 64) {
            const int c = F.tid < 32 ? (int)__hip_atomic_load(F.ctl + CW_CNT + 16 * (F.tid & 31), RLX_AGENT) : 0; const int nb = (c + 255) >> 8; int s = nb;
#pragma unroll
            for (int o = 1; o < 32; o <<= 1) { const int v = __shfl_up(s, o); if ((F.tid & 63) >= o) s += v; }
            if (F.tid < 32) { cn[F.tid] = c; bs[F.tid] = s - nb; if (F.tid == 31) bs[NEXP] = s; }
        }
        __syncthreads();
        if (F.tid < 288) { int e = 0;
#pragma unroll
            for (int j = 1; j < NEXP; ++j) e += (bs[j] <= F.tid) ? 1 : 0;
            b2e[F.tid] = (unsigned char)e; }
        __syncthreads();
    }
    MoeTab t; t.blkstart = bs; t.cnt = cn; t.b2e = b2e; return t;
}

__device__ __forceinline__ void combine_pass(Frame& F, const Args& a, unsigned char* ws) {
    typedef unsigned v2u_t __attribute__((ext_vector_type(2))); typedef float f2_t __attribute__((ext_vector_type(2)));
    float* out = a.out; const unsigned char* y = (const unsigned char*)(ws + WS_Y); const bf16* hb = (const bf16*)(ws + WS_XB);
    int tid_ = F.tid; asm volatile("" : "+v"(tid_));
    const int gt = F.vcu * (NWAVES * 64) + tid_, NGT = F.G * NWAVES * 64;
    constexpr int NIT = NTOK * (DM / 8), UNR = 4; constexpr float inv = 1.0f / Y8_SCALE;
    for (int it0 = gt; it0 < NIT; it0 += UNR * NGT) {
        unsigned y0[UNR][2], y1[UNR][2]; v2u_t hv[UNR][2];
#pragma unroll
        for (int u = 0; u < UNR; ++u) { const int it = it0 + u * NGT; if (it < NIT) { const int wch = it >> 6; const size_t tok = (size_t)(wch >> 1); const int col = (wch & 1) * 512 + 4 * (it & 63);
#pragma unroll
            for (int h = 0; h < 2; ++h) { const int c = col + 256 * h;
                y0[u][h] = *(const GAS unsigned*)(y + (2 * tok) * DM + c); y1[u][h] = *(const GAS unsigned*)(y + (2 * tok + 1) * DM + c); hv[u][h] = *(const GAS v2u_t*)(hb + tok * DM + c); } } }
#pragma unroll
        for (int u = 0; u < UNR; ++u) { const int it = it0 + u * NGT; if (it < NIT) { const int wch = it >> 6; const size_t tok = (size_t)(wch >> 1); const int col = (wch & 1) * 512 + 4 * (it & 63);
#pragma unroll
            for (int h = 0; h < 2; ++h) {
                const f2_t a0 = __builtin_amdgcn_cvt_pk_f32_fp8((int)y0[u][h], false), a1 = __builtin_amdgcn_cvt_pk_f32_fp8((int)y0[u][h], true);
                const f2_t b0 = __builtin_amdgcn_cvt_pk_f32_fp8((int)y1[u][h], false), b1 = __builtin_amdgcn_cvt_pk_f32_fp8((int)y1[u][h], true);
                f32x4 o;
                o[0] = __builtin_bit_cast(float, hv[u][h][0] << 16) + (a0[0] + b0[0]) * inv; o[1] = __builtin_bit_cast(float, hv[u][h][0] & 0xffff0000u) + (a0[1] + b0[1]) * inv;
                o[2] = __builtin_bit_cast(float, hv[u][h][1] << 16) + (a1[0] + b1[0]) * inv; o[3] = __builtin_bit_cast(float, hv[u][h][1] & 0xffff0000u) + (a1[1] + b1[1]) * inv;
                __builtin_nontemporal_store(o, (GAS f32x4*)(out + tok * DM + col + 256 * h)); } } }
    }
}

constexpr int N_PHASES = 8;
#ifndef MK_SPLIT
#define MK_SPLIT 0
#endif
__device__ __forceinline__ Args load_args() {
#if defined(__HIP_DEVICE_COMPILE__)
    auto kp = __builtin_amdgcn_kernarg_segment_ptr(); asm volatile("" : "+s"(kp));
    typedef const __attribute__((address_space(4))) Args* CArgsP; const CArgsP ap = (CArgsP)kp; Args a;
#pragma unroll
    for (int i = 0; i < 21; ++i) a.in[i] = ap->in[i];
    a.out = ap->out; a.ws = ap->ws; a.ph_lo = ap->ph_lo; a.ph_hi = ap->ph_hi; return a;
#else
    return Args{};
#endif
}
__global__ void __launch_bounds__(NWAVES * 64, 2) hymba_fwd(Args args) {
    extern __shared__ __attribute__((aligned(16))) unsigned char lds[];
    Frame F;
    F.lds = (LAS unsigned char*)lds;
    F.MISC = (volatile LAS unsigned*)(F.lds + MISC_OFF);
    F.tid = threadIdx.x; F.lane = F.tid & 63; F.wave = __builtin_amdgcn_readfirstlane(F.tid >> 6);
    F.G = gridDim.x; { const int bx = blockIdx.x; F.vcu = (F.G % 8 == 0) ? (bx % 8) * (F.G / 8) + bx / 8 : bx; }
    unsigned char* ws = args.ws;
    F.ctl = (gu32*)(ws + WS_CTL);
    for (int u = F.tid; u < (LDS_BYTES - LDSCTL_OFF) / 4; u += NWAVES * 64) ((LAS unsigned*)(F.lds + LDSCTL_OFF))[u] = 0u;
    __syncthreads();
    const int lo = args.ph_lo, hi = args.ph_hi;
    XcdBarrier bar; bar.bar = (unsigned*)(F.ctl + CW_BAR); bar.x = 0; bar.st = nullptr;
    if (hi - lo > 1) bar = xcd_barrier_post((unsigned*)(F.ctl + CW_BAR), F.MISC + 8);
#ifndef PHASE_MASK
#define PHASE_MASK 0xff
#endif
#define IN(k) (((PHASE_MASK >> (k)) & 1) && lo <= (k) && (k) < hi)
#define SEAM(k) do { if (IN(k) && IN((k) + 1)) xcd_barrier(bar); } while (0)
#define SEAMW2(k, lo_, hi_) do { if (IN(k) && IN((k) + 1)) xcd_barrier_work(bar, [&]() { const Args aw = load_args(); const int s_ = (int)blockIdx.x * 7 + (F.wave - 1); \
        for (int i_ = (lo_) + s_; i_ < (hi_); i_ += 2 * F.G * 7) ewc_pair(F, aw, ws, i_, i_ + F.G * 7, hi_); }); } while (0)
#define SEAMW(k, lo_, hi_) do { if (IN(k) && IN((k) + 1)) xcd_barrier_work(bar, [&]() { const Args aw = load_args(); expert_weight_copies(F, aw, ws, (int)blockIdx.x * 7 + (F.wave - 1), F.G * 7, lo_, hi_); }); } while (0)

    if (IN(0)) { const Args a0 = load_args(); p0_prologue(F, a0, ws); SEAM(0); }
#if defined(BAR_PROBE)
    if (hi - lo > 1) for (int i_ = 0; i_ < BAR_PROBE; ++i_) xcd_barrier(bar);
#endif

    if (IN(1)) {
        const int nu1 = MROWS / 256 * (INCOLS / 256), heavy = nu1 % F.G, rel = (int)blockIdx.x - heavy, nskew = (F.G - heavy) / 2, s1 = 3 * nskew * NWAVES < EWC_SPLIT ? 3 * nskew * NWAVES : EWC_SPLIT;
        const bool skew = rel >= 0 && (rel & 1);
        if (skew) { const Args ap = load_args(); expert_weight_copies(F, ap, ws, (rel >> 1) * NWAVES + F.wave, nskew * NWAVES, 0, s1); __syncthreads(); }
        pg8::Gemm g{(const bf16*)(ws + WS_XB), (const bf16*)(ws + WS_WIN), MROWS, INCOLS, DM}; pg8::StaticOrder S; S.init(MROWS, INCOLS, F.G, (int)blockIdx.x);
#if defined(EPI_VAR)
        S.skip_epi = (EPI_VAR == 1) && (hi - lo == 1);
#endif
        const Args a1 = load_args();
        EpiInProj E{(bf16*)(ws + WS_CB), (bf16*)(ws + WS_CCX), (bf16*)(ws + WS_Q), (bf16*)(ws + WS_K), (bf16*)(ws + WS_V),
                    (const float*)(ws + WS_ROPEC), (const float*)(ws + WS_ROPES), a1.in[5], a1.in[6]};
        pg8::gemm_phase<EpiInProj, pg8::StaticOrder, true, false>(F.lds + RING_OFF, g, S, E);
        if (rel >= 0 && !skew) expert_weight_copies(F, a1, ws, (rel >> 1) * NWAVES + F.wave, (F.G - heavy - nskew) * NWAVES, s1, EWC_SPLIT);
        SEAM(1);
    }

    if (IN(2)) {
        bool do_conv = true;
#if defined(ATT_VAR)
        do_conv = (hi - lo != 1);
#endif
        { const Args a2 = load_args(); att::attn_phase(F, a2, ws, do_conv); } SEAMW2(2, EWC_SPLIT, EWC_GU + 4 * F.G); }

    if (IN(3)) {
        pg8::Gemm g{(const bf16*)(ws + WS_MIX), (const bf16*)(ws + WS_WOUT), NTOK, DM, DM}; pg8::StaticOrder S; S.init(NTOK, DM, F.G, (int)blockIdx.x);
#if defined(EPI_VAR)
        S.skip_epi = (EPI_VAR == 1) && (hi - lo == 1);
#endif
        EpiOutProj E{(bf16*)(ws + WS_XB), ws + WS_HQ, (const float*)(ws + WS_RSTD1)};
        pg8::gemm_phase<EpiOutProj, pg8::StaticOrder, true, false>(F.lds + RING_OFF, g, S, E);
        SEAM(3);
    }

    if (IN(4)) { const Args a4 = load_args(); router_phase(F, a4, ws); SEAM(4); }

    if (IN(5)) {
        const MoeTab tb = moe_tables(F, false);
        MoeOrderT<false> S{F.G, (int)blockIdx.x, 4 * tb.blkstart[NEXP], DM  , tb, (const int*)(ws + WS_ROWPAIR)};
#if defined(EPI_VAR)
        S.skip_epi = (EPI_VAR == 1) && (hi - lo == 1);
#endif
        pg8::Gemm g{(const bf16*)(ws + WS_HQ), (const bf16*)(ws + WS_WGU), 0, NEXP * 1024, DM};
        EpiMoe1 E{tb, (const float*)(ws + WS_ROWRS), ws + WS_HID};
        pg8::gemm_phase<EpiMoe1, MoeOrderT<false>, true, true, true>(F.lds + RING_OFF, g, S, E);
        { const int r5 = S.nunits % F.G;
          if ((int)blockIdx.x >= r5) { const Args a5 = load_args(); const int nsl5 = (F.G - r5) * NWAVES;
              for (int i5 = EWC_GU + 4 * F.G + ((int)blockIdx.x - r5) * NWAVES + F.wave; i5 < EWC_ITEMS; i5 += 2 * nsl5) ewc_pair(F, a5, ws, i5, i5 + nsl5, EWC_ITEMS); } }
        SEAM(5);
    }

    if (IN(6)) {
        const MoeTab tb = moe_tables(F, IN(5));
        MoeOrderT<true> S{F.G, (int)blockIdx.x, 4 * tb.blkstart[NEXP], DFF  , tb, (const int*)(ws + WS_ROWPAIR)};
#if defined(EPI_VAR)
        S.skip_epi = (EPI_VAR == 1) && (hi - lo == 1);
#endif
        pg8::Gemm g{(const bf16*)(ws + WS_HID), (const bf16*)(ws + WS_WD), 0, NEXP * DM, DFF};
        EpiMoe2 E{tb, (const int*)(ws + WS_ROWPAIR), (bf16*)(ws + WS_Y)};
        pg8::gemm_phase<EpiMoe2, MoeOrderT<true>, true, true, true>(F.lds + RING_OFF, g, S, E);
        SEAM(6);
    }

    if (IN(7)) { const Args a7 = load_args(); combine_pass(F, a7, ws); }
#undef IN
#undef SEAM
}

extern "C" void kernel_launch(void* const* d_in, const int* in_sizes, int n_in, void* d_out, int out_size, void* d_ws, size_t ws_size, hipStream_t stream) {
    static int grid = 0;
    if (grid == 0) {
        if (n_in != 21 || in_sizes[0] != NTOK * DM || out_size != NTOK * DM || ws_size < WS_NEED) { fprintf(stderr, "kernel_launch: unexpected shapes (n_in %d, in0 %d, out %d, ws %zu)\n", n_in, n_in > 0 ? in_sizes[0] : -1, out_size, ws_size); grid = -1; return; }
        int dev = 0, cus = 0, per_cu = 0;
        if (hipGetDevice(&dev) != hipSuccess || hipDeviceGetAttribute(&cus, hipDeviceAttributeMultiprocessorCount, dev) != hipSuccess) { grid = -1; return; }
        if (hipFuncSetAttribute((const void*)hymba_fwd, hipFuncAttributeMaxDynamicSharedMemorySize, LDS_BYTES) != hipSuccess) { fprintf(stderr, "kernel_launch: hipFuncSetAttribute failed\n"); grid = -1; return; }
        if (hipOccupancyMaxActiveBlocksPerMultiprocessor(&per_cu, (const void*)hymba_fwd, NWAVES * 64, LDS_BYTES) != hipSuccess || per_cu < 1) { fprintf(stderr, "kernel_launch: occupancy query says %d\n", per_cu); (void)hipGetLastError(); grid = -1; return; }
        grid = cus;
    }
    if (grid < 0) return;
    if (hipMemsetAsync((char*)d_ws + WS_CTL, 0, CTL_ZERO_BYTES, stream) != hipSuccess) return;
    Args a{};
    for (int i = 0; i < 21; ++i) a.in[i] = (const float*)d_in[i];
    a.out = (float*)d_out; a.ws = (unsigned char*)d_ws;
#if defined(REP_MASK)
    { int k = 0; while (!((REP_MASK >> k) & 1)) ++k;
      a.ph_lo = 0; a.ph_hi = k + 1; hipLaunchKernelGGL(hymba_fwd, dim3(grid), dim3(NWAVES * 64), LDS_BYTES, stream, a);
      if (hipMemsetAsync((char*)d_ws + WS_CTL + CW_BAR * 4, 0, XCD_BAR_WORDS * 4, stream) != hipSuccess) return;
      a.ph_lo = k; a.ph_hi = k + 1; hipLaunchKernelGGL(hymba_fwd, dim3(grid), dim3(NWAVES * 64), LDS_BYTES, stream, a);
      if (k + 1 < N_PHASES) { a.ph_lo = k + 1; a.ph_hi = N_PHASES; hipLaunchKernelGGL(hymba_fwd, dim3(grid), dim3(NWAVES * 64), LDS_BYTES, stream, a); } }
#elif MK_SPLIT
    for (int p = 0; p < N_PHASES; ++p) { a.ph_lo = p; a.ph_hi = p + 1; hipLaunchKernelGGL(hymba_fwd, dim3(grid), dim3(NWAVES * 64), LDS_BYTES, stream, a); }
#else
    a.ph_lo = 0; a.ph_hi = N_PHASES;
    hipLaunchKernelGGL(hymba_fwd, dim3(grid), dim3(NWAVES * 64), LDS_BYTES, stream, a);
#endif
}
```
